# Optimizing an MI355X kernel written in HIP

```python
import jax, jax.numpy as jnp
from jax import lax
import numpy as np

D_MODEL = 1024
BATCH = 32
SEQ = 2048
DEPTH = 1

D_MIX = D_MODEL
GLA_HEADS = 4
GLA_HEAD_V = (D_MIX // 2) // GLA_HEADS
GLA_HEAD_K = GLA_HEAD_V // 2
GLA_GATE_RANK = 16
GLA_GATE_TAU = 16.0
GLA_CHUNK = 64
MOBA_HEADS = 4
MOBA_HEAD_DIM = (D_MIX - GLA_HEADS * GLA_HEAD_V) // MOBA_HEADS
MOBA_BLOCK = 256
MOBA_TOPK = 3
MOBA_QUERY_GROUP = 8
ROPE_THETA = 10000.0
D_FF = -(-8 * D_MODEL // (3 * 256)) * 256
EPS = 1e-6

GLA_QK = GLA_HEADS * GLA_HEAD_K
GLA_V = GLA_HEADS * GLA_HEAD_V
MOBA_W = MOBA_HEADS * MOBA_HEAD_DIM
IN_SIZES = (GLA_QK, GLA_QK, GLA_V, GLA_V, GLA_GATE_RANK, MOBA_W, MOBA_W, MOBA_W)
IN_OFFSETS = tuple(int(o) for o in np.cumsum((0,) + IN_SIZES))
D_IN_PROJ = IN_OFFSETS[-1]

kernel_name = "hymba_gla_moba_hybrid_block"


def rms_norm(x, gain):
    xf = x.astype(jnp.float32)
    y = xf * lax.rsqrt(jnp.mean(xf * xf, axis=-1, keepdims=True) + EPS)
    return (y * gain.astype(jnp.float32)).astype(x.dtype)


def rotary(x, positions):
    half = x.shape[-1] // 2
    inv_freq = jnp.power(ROPE_THETA, -jnp.arange(half, dtype=jnp.float32) / half)
    ang = positions.astype(jnp.float32)[:, :, None] * inv_freq
    cos = jnp.cos(ang)[:, None]
    sin = jnp.sin(ang)[:, None]
    xf = x.astype(jnp.float32)
    x1, x2 = xf[..., :half], xf[..., half:]
    return jnp.concatenate([x1 * cos - x2 * sin, x2 * cos + x1 * sin], axis=-1).astype(x.dtype)


def gla_chunked(q, k, v, log_a):
    B, H, S, dk = q.shape
    dv = v.shape[-1]
    nc = S // GLA_CHUNK
    rs = lambda t: t.reshape(B, H, nc, GLA_CHUNK, t.shape[-1])
    q = rs(q) * (dk ** -0.5)
    k = rs(k)
    v = rs(v)
    b = jnp.cumsum(rs(log_a), axis=3)
    b_last = b[:, :, :, -1:, :]
    q_dec = q * jnp.exp(b)
    k_inv = k * jnp.exp(-b)
    causal = jnp.tril(jnp.ones((GLA_CHUNK, GLA_CHUNK), dtype=bool))
    a = jnp.where(causal, jnp.einsum('bhncd,bhnsd->bhncs', q_dec, k_inv), 0.0)
    o_intra = jnp.einsum('bhncs,bhnsv->bhncv', a, v)
    k_to_end = k * jnp.exp(b_last - b)
    u = jnp.einsum('bhncd,bhncv->bhndv', k_to_end, v)
    chunk_decay = jnp.exp(b_last[:, :, :, 0, :])

    def step(state, inp):
        d, u_c = inp
        return d[..., None] * state + u_c, state

    _, s_prev = lax.scan(step, jnp.zeros((B, H, dk, dv), jnp.float32),
                         (jnp.moveaxis(chunk_decay, 2, 0), jnp.moveaxis(u, 2, 0)))
    s_prev = jnp.moveaxis(s_prev, 0, 2)
    o_inter = jnp.einsum('bhncd,bhndv->bhncv', q_dec, s_prev)
    return (o_intra + o_inter).reshape(B, H, S, dv)


def moba_attention(q, k, v):
    B, H, S, dh = q.shape
    nb = -(-S // MOBA_BLOCK)
    s_pad = nb * MOBA_BLOCK
    pad = ((0, 0), (0, 0), (0, s_pad - S), (0, 0))
    q_p, k_p, v_p = jnp.pad(q, pad), jnp.pad(k, pad), jnp.pad(v, pad)
    kb = k_p.reshape(B, H, nb, MOBA_BLOCK, dh)
    vb = v_p.reshape(B, H, nb, MOBA_BLOCK, dh)
    k_mean = jnp.mean(kb.astype(jnp.float32), axis=3)
    gate = jnp.einsum('bhsd,bhnd->bhsn', q_p.astype(jnp.float32), k_mean)
    q_blk = jnp.arange(s_pad) // MOBA_BLOCK
    past = jnp.arange(nb)[None, :] < q_blk[:, None]
    gate = jnp.where(past, gate, -jnp.inf)
    top = min(MOBA_TOPK, nb)
    _, sel = lax.top_k(gate, top)
    sel_valid = sel < q_blk[None, None, :, None]
    scale = dh ** -0.5
    bi = jnp.arange(B)[:, None, None, None]
    hi = jnp.arange(H)[None, :, None, None]
    G = MOBA_QUERY_GROUP

    def group(gi):
        start = gi * G
        qg = lax.dynamic_slice_in_dim(q_p, start, G, axis=2)
        selg = lax.dynamic_slice_in_dim(sel, start, G, axis=2)
        validg = lax.dynamic_slice_in_dim(sel_valid, start, G, axis=2)
        k_sel = kb[bi, hi, selg]
        v_sel = vb[bi, hi, selg]
        s_sel = jnp.einsum('bhgd,bhgnkd->bhgnk', qg, k_sel).astype(jnp.float32) * scale
        s_sel = jnp.where(validg[..., None], s_sel, -jnp.inf).reshape(B, H, G, top * MOBA_BLOCK)
        own = start // MOBA_BLOCK
        k_own = lax.dynamic_slice_in_dim(k_p, own * MOBA_BLOCK, MOBA_BLOCK, axis=2)
        v_own = lax.dynamic_slice_in_dim(v_p, own * MOBA_BLOCK, MOBA_BLOCK, axis=2)
        s_own = jnp.einsum('bhgd,bhkd->bhgk', qg, k_own).astype(jnp.float32) * scale
        qpos = start + jnp.arange(G)
        kpos = own * MOBA_BLOCK + jnp.arange(MOBA_BLOCK)
        s_own = jnp.where(kpos[None, :] <= qpos[:, None], s_own, -jnp.inf)
        p = jax.nn.softmax(jnp.concatenate([s_sel, s_own], axis=-1), axis=-1)
        p_sel = p[..., :top * MOBA_BLOCK].reshape(B, H, G, top, MOBA_BLOCK).astype(v.dtype)
        p_own = p[..., top * MOBA_BLOCK:].astype(v.dtype)
        return (jnp.einsum('bhgnk,bhgnkd->bhgd', p_sel, v_sel)
                + jnp.einsum('bhgk,bhkd->bhgd', p_own, v_own))

    out = lax.map(group, jnp.arange(s_pad // G))
    out = jnp.transpose(out, (1, 2, 0, 3, 4)).reshape(B, H, s_pad, dh)
    return out[:, :, :S]


def setup_inputs(seed: int = 0) -> dict:
    key = jax.random.key(seed)
    ks = jax.random.split(key, 16)
    f32 = jnp.float32
    nrm = lambda k, shape, fan: jax.random.normal(k, shape, f32) * (fan ** -0.5)
    gain = lambda k, shape: 1.0 + 0.02 * jax.random.normal(k, shape, f32)
    x = jax.random.normal(ks[0], (BATCH, SEQ, D_MODEL), f32)
    offsets = jax.random.randint(ks[1], (BATCH, 1), 0, 1024, dtype=jnp.int32)
    positions = (offsets + jnp.arange(SEQ, dtype=jnp.int32)[None, :]).astype(jnp.int32)
    return {
        "x": x,
        "positions": positions,
        "norm1_gain": gain(ks[2], (DEPTH, D_MODEL)),
        "w_in": nrm(ks[3], (DEPTH, D_MODEL, D_IN_PROJ), D_MODEL),
        "w_gate_up": nrm(ks[4], (DEPTH, GLA_GATE_RANK, GLA_QK), GLA_GATE_RANK),
        "b_gate": 0.1 * jax.random.normal(ks[5], (DEPTH, GLA_QK), f32),
        "gla_out_gain": gain(ks[6], (DEPTH, GLA_HEAD_V)),
        "moba_out_gain": gain(ks[7], (DEPTH, MOBA_HEAD_DIM)),
        "w_out": nrm(ks[8], (DEPTH, D_MIX, D_MODEL), D_MIX),
        "norm2_gain": gain(ks[9], (DEPTH, D_MODEL)),
        "w_ffn_gate": nrm(ks[10], (DEPTH, D_MODEL, D_FF), D_MODEL),
        "w_ffn_up": nrm(ks[11], (DEPTH, D_MODEL, D_FF), D_MODEL),
        "w_ffn_down": nrm(ks[12], (DEPTH, D_FF, D_MODEL), D_FF),
        "final_norm_gain": gain(ks[13], (D_MODEL,)),
    }


def reference(x, positions, norm1_gain, w_in, w_gate_up, b_gate, gla_out_gain, moba_out_gain,
              w_out, norm2_gain, w_ffn_gate, w_ffn_up, w_ffn_down, final_norm_gain):
    B, S, _ = x.shape
    dt = x.dtype
    to_heads = lambda t, h: t.reshape(B, S, h, -1).transpose(0, 2, 1, 3)
    for l in range(DEPTH):
        h = rms_norm(x, norm1_gain[l])
        proj = h @ w_in[l]
        parts = [proj[..., IN_OFFSETS[i]:IN_OFFSETS[i + 1]] for i in range(len(IN_SIZES))]
        gq, gk, gv, gr, g_low, mq, mk, mv = parts
        gate_logit = (g_low @ w_gate_up[l] + b_gate[l]).astype(jnp.float32)
        log_a = jax.nn.log_sigmoid(gate_logit) / GLA_GATE_TAU
        o_gla = gla_chunked(to_heads(gq, GLA_HEADS).astype(jnp.float32),
                            to_heads(gk, GLA_HEADS).astype(jnp.float32),
                            to_heads(gv, GLA_HEADS).astype(jnp.float32),
                            to_heads(log_a, GLA_HEADS)).astype(dt)
        o_gla = rms_norm(o_gla.transpose(0, 2, 1, 3), gla_out_gain[l])
        o_gla = (o_gla * jax.nn.silu(gr.reshape(B, S, GLA_HEADS, GLA_HEAD_V))).reshape(B, S, GLA_V)
        q_m = rotary(to_heads(mq, MOBA_HEADS), positions)
        k_m = rotary(to_heads(mk, MOBA_HEADS), positions)
        o_moba = moba_attention(q_m, k_m, to_heads(mv, MOBA_HEADS))
        o_moba = rms_norm(o_moba.transpose(0, 2, 1, 3), moba_out_gain[l]).reshape(B, S, MOBA_W)
        x = x + jnp.concatenate([o_gla, o_moba], axis=-1) @ w_out[l]
        h = rms_norm(x, norm2_gain[l])
        x = x + (jax.nn.silu(h @ w_ffn_gate[l]) * (h @ w_ffn_up[l])) @ w_ffn_down[l]
    return rms_norm(x, final_norm_gain)
```

```cpp
#include <hip/hip_runtime.h>
#include <cstdio>
#include <cstdint>

constexpr int BATCH = 32, SEQ = 2048, DM = 1024, T = BATCH * SEQ;
constexpr int DFF = 2816, NIN = 3088, NINP = 3328;
constexpr float EPS = 1e-6f;
constexpr int C_GQ = 0, C_GK = 256, C_GV = 512, C_GR = 1024, C_GLOW = 1536, C_MQ = 1552, C_MK = 2064, C_MV = 2576;

typedef unsigned short bf16;
typedef unsigned v4u __attribute__((ext_vector_type(4)));
typedef float f32x4 __attribute__((ext_vector_type(4)));

constexpr size_t MiB = 1u << 20;
constexpr size_t WS_CTL = 0, CTL_ZERO_BYTES = 1 * MiB;
constexpr size_t WS_WIN = 1 * MiB;
constexpr size_t WS_WOUT = 8 * MiB;
constexpr size_t WS_WGU = 10 * MiB;
constexpr size_t WS_WDN = 21 * MiB;
constexpr size_t WS_SS1 = 27 * MiB;
constexpr size_t WS_KSUM = 27 * MiB + 512 * 1024;
constexpr size_t WS_SS2 = 29 * MiB;
constexpr size_t WS_SS3 = 33 * MiB;
constexpr size_t WS_GLOW = 37 * MiB;
constexpr size_t WS_KSO = 41 * MiB;
constexpr size_t WS_ROPE = 42 * MiB;
constexpr size_t WS_XB = 74 * MiB;
constexpr size_t WS_O = 202 * MiB;
constexpr size_t WS_GQ = 330 * MiB;
constexpr size_t WS_GK = 362 * MiB;
constexpr size_t WS_GV = 394 * MiB;
constexpr size_t WS_GR = 458 * MiB;
constexpr size_t WS_GB = 522 * MiB;
constexpr size_t WS_MQ = 586 * MiB;
constexpr size_t WS_MK = 650 * MiB;
constexpr size_t WS_MV = 714 * MiB;
constexpr size_t WS_HMID = 330 * MiB;
constexpr size_t WS_END = 778 * MiB;

__device__ __forceinline__ unsigned f2bf(float f) { unsigned u = __builtin_bit_cast(unsigned, f); return (u + 0x7fffu + ((u >> 16) & 1u)) >> 16; }
__device__ __forceinline__ unsigned pk2(float lo, float hi) { return f2bf(lo) | (f2bf(hi) << 16); }
__device__ __forceinline__ float bf2f(unsigned short u) { return __builtin_bit_cast(float, (unsigned)u << 16); }
__device__ __forceinline__ float wave_sum(float v) {
#pragma unroll
    for (int o = 1; o < 64; o <<= 1) v += __shfl_xor(v, o);
    return v;
}
__device__ __forceinline__ float silu_f(float x) { return x / (1.f + __expf(-x)); }
__device__ __forceinline__ float logsigmoid_f(float x) { return fminf(x, 0.f) - log1pf(__expf(-fabsf(x))); }

struct Ptrs {
    const float* x; const int* pos; const float* g1; const float* w_in; const float* w_gup; const float* b_gate; const float* gla_gain; const float* moba_gain;
    const float* w_out; const float* g2; const float* w_fg; const float* w_fu; const float* w_fd; const float* gf;
    float* out; unsigned char* ws;
};

__host__ __device__ inline int win_src(int np) {
    const int pn = np >> 8, j = np & 255;
    switch (pn) {
    case 0: return C_GQ + j;
    case 1: return C_GK + j;
    case 2: case 3: return C_GV + (pn - 2) * 256 + j;
    case 4: case 5: return C_GR + (pn - 4) * 256 + j;
    case 6: return -1;
    case 7: case 8: case 9: case 10: {
        const int base = pn < 9 ? C_MQ : C_MK, p = pn < 9 ? pn - 7 : pn - 9;
        const int jj = j & 127, head = 2 * p + (jj >> 6), dim = (j >> 7) * 64 + (jj & 63);
        return base + head * 128 + dim; }
    default: return C_MV + (pn - 11) * 256 + j;
    }
}
__device__ __forceinline__ void p0_tr_item(const float* W, int ldw, int srcn0, const float* ks, int ksmod, bf16* WT, int ldwt, int destn0, int k0, float* scr, int lane) {
#pragma unroll 8
    for (int i = 0; i < 32; ++i) { const int kk = 2 * i + (lane >> 5), k = k0 + kk; float sc = 1.f; if (ks) sc = ks[ksmod ? (k % ksmod) : k];
        scr[kk * 33 + (lane & 31)] = W[(size_t)k * ldw + srcn0 + (lane & 31)] * sc; }
    __builtin_amdgcn_s_waitcnt(0xc07f); asm volatile("" ::: "memory");
    const int c = lane & 7;
#pragma unroll
    for (int j = 0; j < 4; ++j) { const int n = (lane >> 3) + 8 * j; const float* s = scr + (8 * c) * 33 + n;
        v4u o; o.x = pk2(s[0 * 33], s[1 * 33]); o.y = pk2(s[2 * 33], s[3 * 33]); o.z = pk2(s[4 * 33], s[5 * 33]); o.w = pk2(s[6 * 33], s[7 * 33]);
        *(v4u*)(WT + (size_t)(destn0 + n) * ldwt + k0 + 8 * c) = o; }
    __builtin_amdgcn_s_waitcnt(0xc07f); asm volatile("" ::: "memory");
}
__device__ __forceinline__ void p0_gate_item(const Ptrs& P, bf16* WT, int n0  , int k0, float* scr, int lane) {
    const int n = lane & 31;
    float wu[16];
#pragma unroll
    for (int r = 0; r < 16; ++r) wu[r] = P.w_gup[r * 256 + n0 + n];
    for (int i = 0; i < 32; ++i) { const int kk = 2 * i + (lane >> 5), k = k0 + kk; const float* wr = P.w_in + (size_t)k * NIN + C_GLOW; float a = 0.f;
#pragma unroll
        for (int r = 0; r < 16; ++r) a += wr[r] * wu[r];
        scr[kk * 33 + n] = a * P.g1[k]; }
    __builtin_amdgcn_s_waitcnt(0xc07f); asm volatile("" ::: "memory");
    const int c = lane & 7;
#pragma unroll
    for (int j = 0; j < 4; ++j) { const int nn = (lane >> 3) + 8 * j; const float* s = scr + (8 * c) * 33 + nn;
        v4u o; o.x = pk2(s[0 * 33], s[1 * 33]); o.y = pk2(s[2 * 33], s[3 * 33]); o.z = pk2(s[4 * 33], s[5 * 33]); o.w = pk2(s[6 * 33], s[7 * 33]);
        *(v4u*)(WT + (size_t)(6 * 256 + n0 + nn) * DM + k0 + 8 * c) = o; }
    __builtin_amdgcn_s_waitcnt(0xc07f); asm volatile("" ::: "memory");
}
__device__ __forceinline__ void p0_prologue(const Ptrs& P, float* scr_all, int gw, int NGW, int lane, int wave) {
    float* scr = scr_all + wave * (64 * 33);
    unsigned char* ws = P.ws;
    bf16* WIN = (bf16*)(ws + WS_WIN); bf16* WOUT = (bf16*)(ws + WS_WOUT); bf16* WGU = (bf16*)(ws + WS_WGU); bf16* WDN = (bf16*)(ws + WS_WDN);
    constexpr int I_IN = (NINP / 32) * (DM / 64), I_OUT = (DM / 32) * (DM / 64), I_GU = (2 * DFF / 32) * (DM / 64), I_DN = (DM / 32) * (DFF / 64);
    constexpr int NITEMS = I_IN + I_OUT + I_GU + I_DN;
    for (int it = gw; it < NITEMS; it += NGW) {
        int r = it;
        if (r < I_IN) { const int nb = r / (DM / 64), kb = r % (DM / 64), np0 = nb * 32, src = win_src(np0);
            if (src < 0) p0_gate_item(P, WIN, np0 & 255, kb * 64, scr, lane);
            else p0_tr_item(P.w_in, NIN, src, P.g1, 0, WIN, DM, np0, kb * 64, scr, lane);
            continue; }
        r -= I_IN;
        if (r < I_OUT) { const int nb = r / (DM / 64), kb = r % (DM / 64), k0 = kb * 64;
            p0_tr_item(P.w_out, DM, nb * 32, k0 < 512 ? P.gla_gain : P.moba_gain, 128, WOUT, DM, nb * 32, k0, scr, lane); continue; }
        r -= I_OUT;
        if (r < I_GU) { const int nb = r / (DM / 64), kb = r % (DM / 64), np0 = nb * 32, pn = np0 >> 8, j = np0 & 255;
            const float* W = j < 128 ? P.w_fg : P.w_fu; const int src = pn * 128 + (j & 127);
            p0_tr_item(W, DFF, src, P.g2, 0, WGU, DM, np0, kb * 64, scr, lane); continue; }
        r -= I_GU;
        { const int nb = r / (DFF / 64), kb = r % (DFF / 64);
            p0_tr_item(P.w_fd, DM, nb * 32, nullptr, 0, WDN, DFF, nb * 32, kb * 64, scr, lane); }
    }
    bf16* XB = (bf16*)(ws + WS_XB); float* SS1 = (float*)(ws + WS_SS1);
    for (int m = gw; m < T; m += NGW) {
        const f32x4* xr = (const f32x4*)(P.x + (size_t)m * DM) + lane; f32x4 v[4]; float s = 0.f;
#pragma unroll
        for (int j = 0; j < 4; ++j) { v[j] = xr[64 * j]; s += (v[j].x * v[j].x + v[j].y * v[j].y) + (v[j].z * v[j].z + v[j].w * v[j].w); }
        s = wave_sum(s);
        unsigned long long* o8 = (unsigned long long*)(XB + (size_t)m * DM) + lane;
#pragma unroll
        for (int j = 0; j < 4; ++j) o8[64 * j] = (unsigned long long)pk2(v[j].x, v[j].y) | ((unsigned long long)pk2(v[j].z, v[j].w) << 32);
        if (lane == 0) SS1[m] = s;
    }
    float2* ROPE = (float2*)(ws + WS_ROPE);
    const float invf = powf(10000.0f, -(float)lane / 64.0f);
    for (int m = gw; m < T; m += NGW) { const float ang = (float)P.pos[m] * invf; float sn, cs; sincosf(ang, &sn, &cs); ROPE[(size_t)m * 64 + lane] = make_float2(cs, sn); }
    float* KSO = (float*)(ws + WS_KSO);
    if (gw == 0) for (int k = lane; k < DM; k += 64) KSO[k] = k < 512 ? P.gla_gain[k & 127] : P.moba_gain[k & 127];
}
__global__ __launch_bounds__(256) void k_prep(Ptrs P) {
    __shared__ float scr[4 * 64 * 33];
    const int lane = threadIdx.x & 63, wave = threadIdx.x >> 6;
    p0_prologue(P, scr, blockIdx.x * 4 + wave, gridDim.x * 4, lane, wave);
}

template <class Epi, bool DUAL>
__global__ __launch_bounds__(256) void naive_gemm(const bf16* A, int lda, const float* B0, const float* B1, int ldb, const float* ks, int M, int N, int K, Epi epi) {
    __shared__ float As[16][68]; __shared__ float Bs0[16][68]; __shared__ float Bs1[DUAL ? 16 : 1][68];
    const int tid = threadIdx.x, tx = tid & 15, ty = tid >> 4, m0 = blockIdx.y * 64, n0 = blockIdx.x * 64;
    float acc0[4][4] = {}, acc1[4][4] = {};
    for (int k0 = 0; k0 < K; k0 += 16) {
        { const int row = tid >> 2, k4 = (tid & 3) * 4; const unsigned long long w = *(const unsigned long long*)(A + (size_t)(m0 + row) * lda + k0 + k4);
#pragma unroll
          for (int i = 0; i < 4; ++i) { const int k = k0 + k4 + i; As[k4 + i][row] = bf2f((unsigned short)(w >> (16 * i))) * (ks ? ks[k] : 1.f); } }
        { const int k = tid >> 4, n4 = (tid & 15) * 4; f32x4 b = {0, 0, 0, 0}, c = {0, 0, 0, 0};
          if (n0 + n4 < N) { b = *(const f32x4*)(B0 + (size_t)(k0 + k) * ldb + n0 + n4); if (DUAL) c = *(const f32x4*)(B1 + (size_t)(k0 + k) * ldb + n0 + n4); }
          *(f32x4*)&Bs0[k][n4] = b; if (DUAL) *(f32x4*)&Bs1[k][n4] = c; }
        __syncthreads();
#pragma unroll
        for (int k = 0; k < 16; ++k) { const f32x4 a = *(const f32x4*)&As[k][ty * 4]; const f32x4 b = *(const f32x4*)&Bs0[k][tx * 4]; f32x4 c = {0, 0, 0, 0}; if (DUAL) c = *(const f32x4*)&Bs1[k][tx * 4];
#pragma unroll
            for (int i = 0; i < 4; ++i)
#pragma unroll
                for (int j = 0; j < 4; ++j) { acc0[i][j] += a[i] * b[j]; if (DUAL) acc1[i][j] += a[i] * c[j]; } }
        __syncthreads();
    }
#pragma unroll
    for (int i = 0; i < 4; ++i)
#pragma unroll
        for (int j = 0; j < 4; ++j) { const int col = n0 + tx * 4 + j; if (col < N) epi(m0 + ty * 4 + i, col, acc0[i][j], acc1[i][j]); }
}
struct EpiInN { unsigned char* ws;
    __device__ void operator()(int row, int col, float v, float) const {
        const float r1 = rsqrtf(((const float*)(ws + WS_SS1))[row] * (1.f / DM) + EPS); v *= r1;
        const int b = row >> 11, s = row & 2047;
        if (col < C_GK) { const int h = col >> 6, d = col & 63; ((bf16*)(ws + WS_GQ))[(((size_t)b * 4 + h) * SEQ + s) * 64 + d] = (bf16)f2bf(v); }
        else if (col < C_GV) { const int c = col - C_GK, h = c >> 6, d = c & 63; ((bf16*)(ws + WS_GK))[(((size_t)b * 4 + h) * SEQ + s) * 64 + d] = (bf16)f2bf(v); }
        else if (col < C_GR) { const int c = col - C_GV, h = c >> 7, d = c & 127; ((bf16*)(ws + WS_GV))[(((size_t)b * 4 + h) * SEQ + s) * 128 + d] = (bf16)f2bf(v); }
        else if (col < C_GLOW) { ((bf16*)(ws + WS_GR))[(size_t)row * 512 + col - C_GR] = (bf16)f2bf(silu_f(v)); }
        else if (col < C_MQ) { ((float*)(ws + WS_GLOW))[(size_t)row * 16 + col - C_GLOW] = v; }
        else { const int c = col - C_MQ, which = c >> 9, cc = c & 511, h = cc >> 7, d = cc & 127;
            bf16* dst = (bf16*)(ws + (which == 0 ? WS_MQ : which == 1 ? WS_MK : WS_MV)); dst[(((size_t)b * 4 + h) * SEQ + s) * 128 + d] = (bf16)f2bf(v); }
    } };
struct EpiOutN { unsigned char* ws; const float* x; float* out;
    __device__ void operator()(int row, int col, float v, float) const { const float x1 = x[(size_t)row * DM + col] + v; out[(size_t)row * DM + col] = x1; ((bf16*)(ws + WS_XB))[(size_t)row * DM + col] = (bf16)f2bf(x1); } };
struct EpiUpN { unsigned char* ws;
    __device__ void operator()(int row, int col, float g, float u) const { const float* ss = (const float*)(ws + WS_SS2) + (size_t)row * 16; float s = 0.f; for (int i = 0; i < 16; ++i) s += ss[i];
        const float r2 = rsqrtf(s * (1.f / DM) + EPS); g *= r2; u *= r2; ((bf16*)(ws + WS_HMID))[(size_t)row * DFF + col] = (bf16)f2bf(silu_f(g) * u); } };
struct EpiDnN { float* out;
    __device__ void operator()(int row, int col, float v, float) const { out[(size_t)row * DM + col] += v; } };

__global__ void naive_gate_cumsum(Ptrs P) {
    const int idx = blockIdx.x * 256 + threadIdx.x, ch = idx >> 8, j = idx & 255, h = j >> 6, d = j & 63;
    const float* GLOW = (const float*)(P.ws + WS_GLOW); float* GB = (float*)(P.ws + WS_GB);
    float wu[16];
#pragma unroll
    for (int r = 0; r < 16; ++r) wu[r] = P.w_gup[r * 256 + j];
    const float bg = P.b_gate[j]; float run = 0.f;
    for (int c = 0; c < 64; ++c) { const int t = ch * 64 + c, b = t >> 11, s = t & 2047; float lg = bg;
#pragma unroll
        for (int r = 0; r < 16; ++r) lg += GLOW[(size_t)t * 16 + r] * wu[r];
        run += logsigmoid_f(lg) * (1.f / 16.f);
        GB[(((size_t)b * 4 + h) * SEQ + s) * 64 + d] = run; }
}
__global__ void naive_rotary(Ptrs P) {
    const size_t idx = (size_t)blockIdx.x * 256 + threadIdx.x; const int i = idx & 63, h = (idx >> 6) & 3; const size_t t = (idx >> 8) & (T - 1); const int which = (int)(idx >> 24);
    bf16* X = (bf16*)(P.ws + (which ? WS_MK : WS_MQ)); const int b = (int)(t >> 11), s = (int)(t & 2047);
    bf16* p = X + (((size_t)b * 4 + h) * SEQ + s) * 128; const float2 cs = ((const float2*)(P.ws + WS_ROPE))[t * 64 + i];
    const float x1 = bf2f(p[i]), x2 = bf2f(p[i + 64]); p[i] = (bf16)f2bf(x1 * cs.x - x2 * cs.y); p[i + 64] = (bf16)f2bf(x2 * cs.x + x1 * cs.y);
}
__global__ void naive_ksum(Ptrs P) {
    const int idx = blockIdx.x * 256 + threadIdx.x, pm = idx >> 9, c = idx & 511, h = c >> 7, d = c & 127, b = pm >> 3, blk = pm & 7;
    const bf16* MK = (const bf16*)(P.ws + WS_MK); float s = 0.f;
    for (int kk = 0; kk < 256; ++kk) s += bf2f(MK[(((size_t)b * 4 + h) * SEQ + blk * 256 + kk) * 128 + d]);
    float* KS = (float*)(P.ws + WS_KSUM); KS[((size_t)pm * 2 + 0) * 512 + c] = s; KS[((size_t)pm * 2 + 1) * 512 + c] = 0.f;
}
__global__ __launch_bounds__(512) void naive_gla(Ptrs P) {
    __shared__ float qs[64], ks[64], as[64], vs[128], part[4][128], o2[128];
    const int bh = blockIdx.x, tid = threadIdx.x, v = tid & 127, g = tid >> 7;
    const bf16* GQ = (const bf16*)(P.ws + WS_GQ) + (size_t)bh * SEQ * 64; const bf16* GK = (const bf16*)(P.ws + WS_GK) + (size_t)bh * SEQ * 64;
    const bf16* GV = (const bf16*)(P.ws + WS_GV) + (size_t)bh * SEQ * 128; const float* GB = (const float*)(P.ws + WS_GB) + (size_t)bh * SEQ * 64;
    const bf16* GR = (const bf16*)(P.ws + WS_GR); bf16* O = (bf16*)(P.ws + WS_O); const int b = bh >> 2, h = bh & 3;
    float S[16];
    for (int i = 0; i < 16; ++i) S[i] = 0.f;
    for (int s = 0; s < SEQ; ++s) {
        if (tid < 64) { qs[tid] = bf2f(GQ[(size_t)s * 64 + tid]) * 0.125f; ks[tid] = bf2f(GK[(size_t)s * 64 + tid]);
            const float bc = GB[(size_t)s * 64 + tid], bp = (s & 63) ? GB[(size_t)(s - 1) * 64 + tid] : 0.f; as[tid] = __expf(bc - bp); }
        else if (tid < 192) vs[tid - 64] = bf2f(GV[(size_t)s * 128 + tid - 64]);
        __syncthreads();
        float acc = 0.f; const float vv = vs[v];
#pragma unroll
        for (int i = 0; i < 16; ++i) { const int d = g * 16 + i; S[i] = as[d] * S[i] + ks[d] * vv; acc += qs[d] * S[i]; }
        part[g][v] = acc;
        __syncthreads();
        float o = 0.f;
        if (tid < 128) { o = part[0][tid] + part[1][tid] + part[2][tid] + part[3][tid]; o2[tid] = o * o; }
        __syncthreads();
        if (tid < 128) { float ss = 0.f; for (int i = 0; i < 128; ++i) ss += o2[i];
            const size_t t = (size_t)b * SEQ + s; const float rs = rsqrtf(ss * (1.f / 128.f) + EPS);
            O[t * DM + h * 128 + tid] = (bf16)f2bf(o * rs * bf2f(GR[t * 512 + h * 128 + tid])); }
    }
}
__global__ __launch_bounds__(256) void naive_moba(Ptrs P) {
    __shared__ float qsh[4][128]; __shared__ float sc[4][1024];
    const int wave = threadIdx.x >> 6, lane = threadIdx.x & 63; const size_t qi = (size_t)blockIdx.x * 4 + wave;
    const int s = (int)(qi & 2047), bh = (int)(qi >> 11), b = bh >> 2, h = bh & 3, qblk = s >> 8;
    const bf16* MQ = (const bf16*)(P.ws + WS_MQ); const bf16* MK = (const bf16*)(P.ws + WS_MK) + (size_t)bh * SEQ * 128; const bf16* MV = (const bf16*)(P.ws + WS_MV) + (size_t)bh * SEQ * 128;
    const float* KS = (const float*)(P.ws + WS_KSUM);
    float* q = qsh[wave]; float* scw = sc[wave];
    q[lane] = bf2f(MQ[qi * 128 + lane]); q[lane + 64] = bf2f(MQ[qi * 128 + lane + 64]);
    __builtin_amdgcn_s_waitcnt(0xc07f); asm volatile("" ::: "memory");
    float g = -__builtin_inff();
    if (lane < 8 && lane < qblk) { const int pm = b * 8 + lane; float a = 0.f;
        for (int d = 0; d < 128; ++d) a += q[d] * (KS[((size_t)pm * 2) * 512 + h * 128 + d] + KS[((size_t)pm * 2 + 1) * 512 + h * 128 + d]) * (1.f / 256.f);
        g = a; }
    float gv[8];
#pragma unroll
    for (int j = 0; j < 8; ++j) gv[j] = __shfl(g, j);
    unsigned sel = 0;
#pragma unroll
    for (int j = 0; j < 8; ++j) { int rank = 0;
#pragma unroll
        for (int k = 0; k < 8; ++k) if (k < qblk && (gv[k] > gv[j] || (gv[k] == gv[j] && k < j))) ++rank;
        if (j < qblk && rank < 3) sel |= 1u << j; }
    const int nsl = __builtin_popcount(sel) + 1;
    const float scale = 0.08838834764831845f;
    float mx = -__builtin_inff();
    for (int blk = 0; blk <= qblk; ++blk) { const bool own = blk == qblk; if (!own && !((sel >> blk) & 1u)) continue;
        const int sl = own ? nsl - 1 : __builtin_popcount(sel & ((1u << blk) - 1u));
        for (int kk = lane; kk < 256; kk += 64) { const int key = blk * 256 + kk; float a = -__builtin_inff();
        if (key <= s) { a = 0.f; const bf16* kr = MK + (size_t)key * 128; for (int d = 0; d < 128; d += 8) { const v4u w = *(const v4u*)(kr + d);
                a += q[d] * bf2f((unsigned short)w.x) + q[d + 1] * bf2f((unsigned short)(w.x >> 16)) + q[d + 2] * bf2f((unsigned short)w.y) + q[d + 3] * bf2f((unsigned short)(w.y >> 16))
                   + q[d + 4] * bf2f((unsigned short)w.z) + q[d + 5] * bf2f((unsigned short)(w.z >> 16)) + q[d + 6] * bf2f((unsigned short)w.w) + q[d + 7] * bf2f((unsigned short)(w.w >> 16)); }
            a *= scale; }
        scw[sl * 256 + kk] = a; mx = fmaxf(mx, a); } }
    for (int o = 1; o < 64; o <<= 1) mx = fmaxf(mx, __shfl_xor(mx, o));
    float sum = 0.f;
    for (int i = lane; i < nsl * 256; i += 64) { const float p = __expf(scw[i] - mx); scw[i] = p; sum += p; }
    sum = wave_sum(sum);
    __builtin_amdgcn_s_waitcnt(0xc07f); asm volatile("" ::: "memory");
    float o0 = 0.f, o1 = 0.f;
    for (int blk = 0; blk <= qblk; ++blk) { const bool own = blk == qblk; if (!own && !((sel >> blk) & 1u)) continue;
        const int sl = own ? nsl - 1 : __builtin_popcount(sel & ((1u << blk) - 1u));
        const int kmax = own ? (s - qblk * 256 + 1) : 256;
        for (int kk = 0; kk < kmax; ++kk) { const float p = scw[sl * 256 + kk]; const bf16* vr = MV + (size_t)(blk * 256 + kk) * 128; o0 += p * bf2f(vr[lane]); o1 += p * bf2f(vr[lane + 64]); } }
    const float inv = 1.f / sum; o0 *= inv; o1 *= inv;
    const float ss = wave_sum(o0 * o0 + o1 * o1), rs = rsqrtf(ss * (1.f / 128.f) + EPS);
    bf16* O = (bf16*)(P.ws + WS_O); const size_t t = (size_t)b * SEQ + s;
    O[t * DM + 512 + h * 128 + lane] = (bf16)f2bf(o0 * rs); O[t * DM + 512 + h * 128 + lane + 64] = (bf16)f2bf(o1 * rs);
}
__global__ void naive_rowss(const float* X, float* SS) {
    const int lane = threadIdx.x & 63; const size_t m = (size_t)blockIdx.x * 4 + (threadIdx.x >> 6);
    const f32x4* xr = (const f32x4*)(X + m * DM) + lane; float s = 0.f;
    for (int j = 0; j < 4; ++j) { const f32x4 v = xr[64 * j]; s += (v.x * v.x + v.y * v.y) + (v.z * v.z + v.w * v.w); }
    s = wave_sum(s);
    if (lane < 16) SS[m * 16 + lane] = lane == 0 ? s : 0.f;
}
__global__ void k_final(Ptrs P) {
    const int lane = threadIdx.x & 63; const size_t m = (size_t)blockIdx.x * 4 + (threadIdx.x >> 6);
    const float* ss = (const float*)(P.ws + WS_SS3) + m * 16; float s = 0.f;
    for (int i = 0; i < 16; ++i) s += ss[i];
    const float r = rsqrtf(s * (1.f / DM) + EPS);
    f32x4* xr = (f32x4*)(P.out + m * DM) + lane; const f32x4* gr = (const f32x4*)P.gf + lane;
    for (int j = 0; j < 4; ++j) { f32x4 v = xr[64 * j]; const f32x4 g = gr[64 * j]; v = v * r * g; xr[64 * j] = v; }
}

extern "C" void kernel_launch(void* const* d_in, const int* in_sizes, int n_in, void* d_out, int out_size, void* d_ws, size_t ws_size, hipStream_t stream) {
    if (n_in != 14 || in_sizes[0] != T * DM || out_size != T * DM || ws_size < WS_END) { fprintf(stderr, "kernel_launch: unexpected shapes (n_in %d, in0 %d, out %d, ws %zu)\n", n_in, n_in > 0 ? in_sizes[0] : -1, out_size, ws_size); return; }
    Ptrs P{};
    P.x = (const float*)d_in[0]; P.pos = (const int*)d_in[1]; P.g1 = (const float*)d_in[2]; P.w_in = (const float*)d_in[3]; P.w_gup = (const float*)d_in[4]; P.b_gate = (const float*)d_in[5];
    P.gla_gain = (const float*)d_in[6]; P.moba_gain = (const float*)d_in[7]; P.w_out = (const float*)d_in[8]; P.g2 = (const float*)d_in[9]; P.w_fg = (const float*)d_in[10]; P.w_fu = (const float*)d_in[11];
    P.w_fd = (const float*)d_in[12]; P.gf = (const float*)d_in[13]; P.out = (float*)d_out; P.ws = (unsigned char*)d_ws;
    unsigned char* ws = P.ws;
    (void)hipMemsetAsync(ws + WS_CTL, 0, CTL_ZERO_BYTES, stream);
    k_prep<<<1024, 256, 0, stream>>>(P);
    naive_gemm<EpiInN, false><<<dim3((NIN + 63) / 64, T / 64), 256, 0, stream>>>((const bf16*)(ws + WS_XB), DM, P.w_in, nullptr, NIN, P.g1, T, NIN, DM, EpiInN{ws});
    naive_gate_cumsum<<<(T / 64) * 256 / 256, 256, 0, stream>>>(P);
    naive_rotary<<<(unsigned)((size_t)2 * T * 4 * 64 / 256), 256, 0, stream>>>(P);
    naive_ksum<<<256 * 512 / 256, 256, 0, stream>>>(P);
    naive_gla<<<BATCH * 4, 512, 0, stream>>>(P);
    naive_moba<<<T * 4 / 4, 256, 0, stream>>>(P);
    naive_gemm<EpiOutN, false><<<dim3(DM / 64, T / 64), 256, 0, stream>>>((const bf16*)(ws + WS_O), DM, P.w_out, nullptr, DM, (const float*)(ws + WS_KSO), T, DM, DM, EpiOutN{ws, P.x, P.out});
    naive_rowss<<<T / 4, 256, 0, stream>>>(P.out, (float*)(ws + WS_SS2));
    naive_gemm<EpiUpN, true><<<dim3(DFF / 64, T / 64), 256, 0, stream>>>((const bf16*)(ws + WS_XB), DM, P.w_fg, P.w_fu, DFF, P.g2, T, DFF, DM, EpiUpN{ws});
    naive_gemm<EpiDnN, false><<<dim3(DM / 64, T / 64), 256, 0, stream>>>((const bf16*)(ws + WS_HMID), DFF, P.w_fd, nullptr, DM, nullptr, T, DM, DFF, EpiDnN{P.out});
    naive_rowss<<<T / 4, 256, 0, stream>>>(P.out, (float*)(ws + WS_SS3));
    k_final<<<T / 4, 256, 0, stream>>>(P);
}
```

```cpp
#include <hip/hip_runtime.h>
#include <cstdio>
#include <cstdint>

constexpr int BATCH = 32, SEQ = 2048, DM = 1024, T = BATCH * SEQ;
constexpr int DFF = 2816, NIN = 3088, NINP = 3328;
constexpr float EPS = 1e-6f;
constexpr int C_GQ = 0, C_GK = 256, C_GV = 512, C_GR = 1024, C_GLOW = 1536, C_MQ = 1552, C_MK = 2064, C_MV = 2576;

typedef unsigned short bf16;
typedef unsigned v4u __attribute__((ext_vector_type(4)));
typedef float f32x4 __attribute__((ext_vector_type(4)));

constexpr size_t MiB = 1u << 20;
constexpr size_t WS_CTL = 0, CTL_ZERO_BYTES = 1 * MiB;
constexpr size_t WS_WIN = 1 * MiB;
constexpr size_t WS_WOUT = 8 * MiB;
constexpr size_t WS_WGU = 10 * MiB;
constexpr size_t WS_WDN = 21 * MiB;
constexpr size_t WS_SS1 = 27 * MiB;
constexpr size_t WS_KSUM = 27 * MiB + 512 * 1024;
constexpr size_t WS_SS2 = 29 * MiB;
constexpr size_t WS_SS3 = 33 * MiB;
constexpr size_t WS_GLOW = 37 * MiB;
constexpr size_t WS_KSO = 41 * MiB;
constexpr size_t WS_ROPE = 42 * MiB;
constexpr size_t WS_XB = 74 * MiB;
constexpr size_t WS_O = 202 * MiB;
constexpr size_t WS_GQ = 330 * MiB;
constexpr size_t WS_GK = 362 * MiB;
constexpr size_t WS_GV = 394 * MiB;
constexpr size_t WS_GR = 458 * MiB;
constexpr size_t WS_GB = 522 * MiB;
constexpr size_t WS_MQ = 586 * MiB;
constexpr size_t WS_MK = 650 * MiB;
constexpr size_t WS_MV = 714 * MiB;
constexpr size_t WS_HMID = 330 * MiB;
constexpr size_t WS_END = 778 * MiB;

__device__ __forceinline__ unsigned f2bf(float f) { unsigned u = __builtin_bit_cast(unsigned, f); return (u + 0x7fffu + ((u >> 16) & 1u)) >> 16; }
__device__ __forceinline__ unsigned pk2(float lo, float hi) { return f2bf(lo) | (f2bf(hi) << 16); }
__device__ __forceinline__ float bf2f(unsigned short u) { return __builtin_bit_cast(float, (unsigned)u << 16); }
__device__ __forceinline__ float wave_sum(float v) {
#pragma unroll
    for (int o = 1; o < 64; o <<= 1) v += __shfl_xor(v, o);
    return v;
}
__device__ __forceinline__ float silu_f(float x) { return x / (1.f + __expf(-x)); }
__device__ __forceinline__ float logsigmoid_f(float x) { return fminf(x, 0.f) - log1pf(__expf(-fabsf(x))); }

struct Ptrs {
    const float* x; const int* pos; const float* g1; const float* w_in; const float* w_gup; const float* b_gate; const float* gla_gain; const float* moba_gain;
    const float* w_out; const float* g2; const float* w_fg; const float* w_fu; const float* w_fd; const float* gf;
    float* out; unsigned char* ws;
};

__host__ __device__ inline int win_src(int np) {
    const int pn = np >> 8, j = np & 255;
    switch (pn) {
    case 0: return C_GQ + j;
    case 1: return C_GK + j;
    case 2: case 3: return C_GV + (pn - 2) * 256 + j;
    case 4: case 5: return C_GR + (pn - 4) * 256 + j;
    case 6: return -1;
    case 7: case 8: case 9: case 10: {
        const int base = pn < 9 ? C_MQ : C_MK, p = pn < 9 ? pn - 7 : pn - 9;
        const int jj = j & 127, head = 2 * p + (jj >> 6), dim = (j >> 7) * 64 + (jj & 63);
        return base + head * 128 + dim; }
    default: return C_MV + (pn - 11) * 256 + j;
    }
}
__device__ __forceinline__ void p0_tr_item(const float* W, int ldw, int srcn0, const float* ks, int ksmod, bf16* WT, int ldwt, int destn0, int k0, float* scr, int lane) {
#pragma unroll 8
    for (int i = 0; i < 32; ++i) { const int kk = 2 * i + (lane >> 5), k = k0 + kk; float sc = 1.f; if (ks) sc = ks[ksmod ? (k % ksmod) : k];
        scr[kk * 33 + (lane & 31)] = W[(size_t)k * ldw + srcn0 + (lane & 31)] * sc; }
    __builtin_amdgcn_s_waitcnt(0xc07f); asm volatile("" ::: "memory");
    const int c = lane & 7;
#pragma unroll
    for (int j = 0; j < 4; ++j) { const int n = (lane >> 3) + 8 * j; const float* s = scr + (8 * c) * 33 + n;
        v4u o; o.x = pk2(s[0 * 33], s[1 * 33]); o.y = pk2(s[2 * 33], s[3 * 33]); o.z = pk2(s[4 * 33], s[5 * 33]); o.w = pk2(s[6 * 33], s[7 * 33]);
        *(v4u*)(WT + (size_t)(destn0 + n) * ldwt + k0 + 8 * c) = o; }
    __builtin_amdgcn_s_waitcnt(0xc07f); asm volatile("" ::: "memory");
}
__device__ __forceinline__ void p0_gate_item(const Ptrs& P, bf16* WT, int n0  , int k0, float* scr, int lane) {
    const int n = lane & 31;
    float wu[16];
#pragma unroll
    for (int r = 0; r < 16; ++r) wu[r] = P.w_gup[r * 256 + n0 + n];
    for (int i = 0; i < 32; ++i) { const int kk = 2 * i + (lane >> 5), k = k0 + kk; const float* wr = P.w_in + (size_t)k * NIN + C_GLOW; float a = 0.f;
#pragma unroll
        for (int r = 0; r < 16; ++r) a += wr[r] * wu[r];
        scr[kk * 33 + n] = a * P.g1[k]; }
    __builtin_amdgcn_s_waitcnt(0xc07f); asm volatile("" ::: "memory");
    const int c = lane & 7;
#pragma unroll
    for (int j = 0; j < 4; ++j) { const int nn = (lane >> 3) + 8 * j; const float* s = scr + (8 * c) * 33 + nn;
        v4u o; o.x = pk2(s[0 * 33], s[1 * 33]); o.y = pk2(s[2 * 33], s[3 * 33]); o.z = pk2(s[4 * 33], s[5 * 33]); o.w = pk2(s[6 * 33], s[7 * 33]);
        *(v4u*)(WT + (size_t)(6 * 256 + n0 + nn) * DM + k0 + 8 * c) = o; }
    __builtin_amdgcn_s_waitcnt(0xc07f); asm volatile("" ::: "memory");
}
__device__ __forceinline__ void p0_prologue(const Ptrs& P, float* scr_all, int gw, int NGW, int lane, int wave) {
    float* scr = scr_all + wave * (64 * 33);
    unsigned char* ws = P.ws;
    bf16* WIN = (bf16*)(ws + WS_WIN); bf16* WOUT = (bf16*)(ws + WS_WOUT); bf16* WGU = (bf16*)(ws + WS_WGU); bf16* WDN = (bf16*)(ws + WS_WDN);
    constexpr int I_IN = (NINP / 32) * (DM / 64), I_OUT = (DM / 32) * (DM / 64), I_GU = (2 * DFF / 32) * (DM / 64), I_DN = (DM / 32) * (DFF / 64);
    constexpr int NITEMS = I_IN + I_OUT + I_GU + I_DN;
    for (int it = gw; it < NITEMS; it += NGW) {
        int r = it;
        if (r < I_IN) { const int nb = r / (DM / 64), kb = r % (DM / 64), np0 = nb * 32, src = win_src(np0);
            if (src < 0) p0_gate_item(P, WIN, np0 & 255, kb * 64, scr, lane);
            else p0_tr_item(P.w_in, NIN, src, P.g1, 0, WIN, DM, np0, kb * 64, scr, lane);
            continue; }
        r -= I_IN;
        if (r < I_OUT) { const int nb = r / (DM / 64), kb = r % (DM / 64), k0 = kb * 64;
            p0_tr_item(P.w_out, DM, nb * 32, k0 < 512 ? P.gla_gain : P.moba_gain, 128, WOUT, DM, nb * 32, k0, scr, lane); continue; }
        r -= I_OUT;
        if (r < I_GU) { const int nb = r / (DM / 64), kb = r % (DM / 64), np0 = nb * 32, pn = np0 >> 8, j = np0 & 255;
            const float* W = j < 128 ? P.w_fg : P.w_fu; const int src = pn * 128 + (j & 127);
            p0_tr_item(W, DFF, src, P.g2, 0, WGU, DM, np0, kb * 64, scr, lane); continue; }
        r -= I_GU;
        { const int nb = r / (DFF / 64), kb = r % (DFF / 64);
            p0_tr_item(P.w_fd, DM, nb * 32, nullptr, 0, WDN, DFF, nb * 32, kb * 64, scr, lane); }
    }
    bf16* XB = (bf16*)(ws + WS_XB); float* SS1 = (float*)(ws + WS_SS1);
    for (int m = gw; m < T; m += NGW) {
        const f32x4* xr = (const f32x4*)(P.x + (size_t)m * DM) + lane; f32x4 v[4]; float s = 0.f;
#pragma unroll
        for (int j = 0; j < 4; ++j) { v[j] = xr[64 * j]; s += (v[j].x * v[j].x + v[j].y * v[j].y) + (v[j].z * v[j].z + v[j].w * v[j].w); }
        s = wave_sum(s);
        unsigned long long* o8 = (unsigned long long*)(XB + (size_t)m * DM) + lane;
#pragma unroll
        for (int j = 0; j < 4; ++j) o8[64 * j] = (unsigned long long)pk2(v[j].x, v[j].y) | ((unsigned long long)pk2(v[j].z, v[j].w) << 32);
        if (lane == 0) SS1[m] = s;
    }
    float2* ROPE = (float2*)(ws + WS_ROPE);
    const float invf = powf(10000.0f, -(float)lane / 64.0f);
    for (int m = gw; m < T; m += NGW) { const float ang = (float)P.pos[m] * invf; float sn, cs; sincosf(ang, &sn, &cs); ROPE[(size_t)m * 64 + lane] = make_float2(cs, sn); }
    float* KSO = (float*)(ws + WS_KSO);
    if (gw == 0) for (int k = lane; k < DM; k += 64) KSO[k] = k < 512 ? P.gla_gain[k & 127] : P.moba_gain[k & 127];
}

namespace pg8 {
#define PG8_LAS __attribute__((address_space(3)))
typedef unsigned short bf16_t;
typedef short bf16x8 __attribute__((ext_vector_type(8)));
typedef float f32x4 __attribute__((ext_vector_type(4)));
typedef unsigned u32x4 __attribute__((ext_vector_type(4)));
constexpr int BM = 256, BK = 64, HALF = 128, HTB = HALF * BK * 2  , STAGE_BYTES = 8 * HTB, NXCD = 8, WGM = 8;

__host__ __device__ __forceinline__ int lds_byte(int r, int c) { const int st = (r >> 4) * 2 + (c >> 5), rr = r & 15, cc = c & 31, ob = rr * 64 + cc * 2; return st * 1024 + (ob ^ (((ob >> 9) & 1) << 5)); }
__host__ __device__ __forceinline__ void stage_rc(int b, int& R, int& C) { const int st = b / 1024, sb = b % 1024, swz = sb ^ (((sb >> 9) & 1) << 5); R = (st >> 1) * 16 + swz / 64; C = (st & 1) * 32 + (swz % 64) / 2; }
__host__ __device__ __forceinline__ int perm32(int rho) { const int n = rho >> 4, i = rho & 15; return 8 * (i >> 2) + 4 * n + (i & 3); }

struct Unit { int pm, pn; };
struct Gemm { const bf16_t* A; const bf16_t* Bt; int M, N, K; };

struct StaticOrder {
    int nM, nN, nwg, G, c;
    __host__ __device__ void init(int M, int N, int G_, int c_) { nM = M / BM; nN = N / BM; nwg = nM * nN; G = G_; c = c_; }
    __host__ __device__ bool next(int i, Unit& u) const {
        const long L = (long)i * G + c; if (L >= nwg) return false;
        int wgid = (int)L; { const int q = nwg / NXCD, r = nwg % NXCD, xcd = wgid % NXCD, off = wgid / NXCD; wgid = (xcd < r ? xcd * (q + 1) : r * (q + 1) + (xcd - r) * q) + off; }
        const int nig = WGM * nN, gid = wgid / nig, fm = gid * WGM, gsz = (nM - fm) < WGM ? (nM - fm) : WGM;
        u.pm = fm + ((wgid % nig) % gsz); u.pn = (wgid % nig) / gsz; return true;
    }
    __device__ __forceinline__ void a_ready(const Unit&) const {}
    __device__ __forceinline__ void done(const Unit&) const {}
};

__device__ __forceinline__ unsigned cvt_pk_bf16(float lo, float hi) { unsigned r; asm volatile("v_cvt_pk_bf16_f32 %0, %1, %2" : "=v"(r) : "v"(lo), "v"(hi)); return r; }
__device__ __forceinline__ u32x4 pack8(f32x4 a, f32x4 b) { u32x4 w; w.x = cvt_pk_bf16(a[0], a[1]); w.y = cvt_pk_bf16(a[2], a[3]); w.z = cvt_pk_bf16(b[0], b[1]); w.w = cvt_pk_bf16(b[2], b[3]); return w; }
__device__ __forceinline__ float fast_silu(float v) { return v * __builtin_amdgcn_rcpf(1.f + __builtin_amdgcn_exp2f(-1.4426950408889634f * v)); }
__device__ __forceinline__ float fast_logsigmoid(float x) { return fminf(x, 0.f) - 0.6931471805599453f * __builtin_amdgcn_logf(1.f + __builtin_amdgcn_exp2f(-1.4426950408889634f * fabsf(x))); }
template <int CTRL> __device__ __forceinline__ float dpp_shr0(float x) { return __builtin_bit_cast(float, __builtin_amdgcn_update_dpp(0, __builtin_bit_cast(int, x), CTRL, 0xf, 0xf, false)); }
__device__ __forceinline__ float row_scan16(float x) { x += dpp_shr0<0x111>(x); x += dpp_shr0<0x112>(x); x += dpp_shr0<0x114>(x); x += dpp_shr0<0x118>(x); return x; }

struct EpiIn {
    static constexpr bool PERM = true, AFTER_DRAIN = false;
    unsigned char* ws; const float* b_gate;
    __device__ __forceinline__ void operator()(const f32x4 (&acc)[2][2][4][2], const Unit& u, int wr, int wc, int fr, int fq) const {
        asm volatile("" : "+v"(fr), "+v"(fq));
        const int pn = u.pn, pm = u.pm, b = pm >> 3, s0 = (pm & 7) * 256 + wr * 64 + fr, t0 = pm * 256 + wr * 64 + fr, lc = wc * 32 + fq * 8;
        float r1[2][4];
#pragma unroll
        for (int ai = 0; ai < 2; ++ai)
#pragma unroll
            for (int m = 0; m < 4; ++m) r1[ai][m] = rsqrtf(((const float*)(ws + WS_SS1))[t0 + ai * 128 + m * 16] * (1.f / DM) + EPS);
        if (pn <= 1) {
            bf16* dst = (bf16*)(ws + (pn == 0 ? WS_GQ : WS_GK));
#pragma unroll
            for (int bj = 0; bj < 2; ++bj) { const int h = 2 * bj + (wc >> 1), d = (wc & 1) * 32 + fq * 8;
#pragma unroll
                for (int ai = 0; ai < 2; ++ai)
#pragma unroll
                    for (int m = 0; m < 4; ++m) { const float r = r1[ai][m];
                        *(u32x4*)(dst + (((size_t)b * 4 + h) * SEQ + s0 + ai * 128 + m * 16) * 64 + d) = pack8(acc[ai][bj][m][0] * r, acc[ai][bj][m][1] * r); } }
        } else if (pn == 2 || pn == 3 || pn >= 11) {
            bf16* dst = (bf16*)(ws + (pn >= 11 ? WS_MV : WS_GV)); const int hb = 2 * (pn >= 11 ? pn - 11 : pn - 2);
#pragma unroll
            for (int bj = 0; bj < 2; ++bj)
#pragma unroll
                for (int ai = 0; ai < 2; ++ai)
#pragma unroll
                    for (int m = 0; m < 4; ++m) { const float r = r1[ai][m];
                        *(u32x4*)(dst + (((size_t)b * 4 + hb + bj) * SEQ + s0 + ai * 128 + m * 16) * 128 + lc) = pack8(acc[ai][bj][m][0] * r, acc[ai][bj][m][1] * r); }
        } else if (pn == 4 || pn == 5) {
            bf16* dst = (bf16*)(ws + WS_GR) + (pn - 4) * 256 + lc;
#pragma unroll
            for (int bj = 0; bj < 2; ++bj)
#pragma unroll
                for (int ai = 0; ai < 2; ++ai)
#pragma unroll
                    for (int m = 0; m < 4; ++m) { const float r = r1[ai][m]; f32x4 v0 = acc[ai][bj][m][0] * r, v1 = acc[ai][bj][m][1] * r;
#pragma unroll
                        for (int i = 0; i < 4; ++i) { v0[i] = fast_silu(v0[i]); v1[i] = fast_silu(v1[i]); }
                        *(u32x4*)(dst + (size_t)(t0 + ai * 128 + m * 16) * 512 + bj * 128) = pack8(v0, v1); }
        } else if (pn == 6) {
            float* dst = (float*)(ws + WS_GB);
#pragma unroll
            for (int bj = 0; bj < 2; ++bj) { const int h = 2 * bj + (wc >> 1), d = (wc & 1) * 32 + fq * 8;
#pragma unroll
                for (int n = 0; n < 2; ++n) { const f32x4 bg = *(const f32x4*)(b_gate + bj * 128 + lc + 4 * n);
#pragma unroll
                    for (int ai = 0; ai < 2; ++ai) { f32x4 run = {0.f, 0.f, 0.f, 0.f};
#pragma unroll
                        for (int m = 0; m < 4; ++m) { f32x4 v = acc[ai][bj][m][n] * r1[ai][m] + bg, tot;
#pragma unroll
                            for (int i = 0; i < 4; ++i) { v[i] = row_scan16(fast_logsigmoid(v[i]) * (1.f / 16.f)); tot[i] = __shfl(v[i], 15, 16); }
                            v = v + run; run = run + tot;
                            *(f32x4*)(dst + (((size_t)b * 4 + h) * SEQ + s0 + ai * 128 + m * 16) * 64 + d + 4 * n) = v; } } } }
        } else {
            const bool isk = pn >= 9; const int p = isk ? pn - 9 : pn - 7, h = 2 * p + (wc >> 1), i0 = (wc & 1) * 32 + fq * 8;
            bf16* dst = (bf16*)(ws + (isk ? WS_MK : WS_MQ)); const f32x4* rope = (const f32x4*)(ws + WS_ROPE);
            typedef unsigned u32x2 __attribute__((ext_vector_type(2)));
#pragma unroll
            for (int n = 0; n < 2; ++n) { f32x4 ks1 = {0.f, 0.f, 0.f, 0.f}, ks2 = ks1;
                unsigned ro = (unsigned)((t0 * 64 + i0) * 8 + n * 32), dof = (unsigned)(((((b * 4 + h) * SEQ + s0) * 128) + i0 + 4 * n) * 2);
                const char* ropeb = (const char*)rope; char* dstb = (char*)dst;
#pragma unroll
                for (int ai = 0; ai < 2; ++ai) {
#pragma unroll
                    for (int m = 0; m < 4; ++m) { const float r = r1[ai][m];
                        const f32x4 c0 = *(const f32x4*)(ropeb + ro), c1 = *(const f32x4*)(ropeb + ro + 16);
                        const f32x4 x = acc[ai][0][m][n] * r, y = acc[ai][1][m][n] * r; f32x4 o1, o2;
                        o1[0] = x[0] * c0[0] - y[0] * c0[1]; o2[0] = y[0] * c0[0] + x[0] * c0[1]; o1[1] = x[1] * c0[2] - y[1] * c0[3]; o2[1] = y[1] * c0[2] + x[1] * c0[3];
                        o1[2] = x[2] * c1[0] - y[2] * c1[1]; o2[2] = y[2] * c1[0] + x[2] * c1[1]; o1[3] = x[3] * c1[2] - y[3] * c1[3]; o2[3] = y[3] * c1[2] + x[3] * c1[3];
                        u32x2 w1, w2; w1.x = cvt_pk_bf16(o1[0], o1[1]); w1.y = cvt_pk_bf16(o1[2], o1[3]); w2.x = cvt_pk_bf16(o2[0], o2[1]); w2.y = cvt_pk_bf16(o2[2], o2[3]);
                        *(u32x2*)(dstb + dof) = w1; *(u32x2*)(dstb + dof + 128) = w2;
                        ks1 = ks1 + o1; ks2 = ks2 + o2;
                        ro += 16 * 512; dof += 16 * 256; asm volatile("" : "+v"(ro), "+v"(dof)); }
                    ro += 64 * 512; dof += 64 * 256; asm volatile("" : "+v"(ro), "+v"(dof)); }
                if (isk) {
#pragma unroll
                    for (int o = 1; o < 16; o <<= 1)
#pragma unroll
                        for (int i = 0; i < 4; ++i) { ks1[i] += __shfl_xor(ks1[i], o); ks2[i] += __shfl_xor(ks2[i], o); }
                    if (fr == 0) { float* kp = (float*)(ws + WS_KSUM) + ((size_t)pm * 2 + wr) * 512 + h * 128 + i0 + 4 * n; *(f32x4*)kp = ks1; *(f32x4*)(kp + 64) = ks2; } } }
        }
    }
};
template <bool BF> struct EpiRes {
    static constexpr bool PERM = true, AFTER_DRAIN = false;
    const float* base; float* out; bf16* xb; float* ss;
    __device__ __forceinline__ void operator()(const f32x4 (&acc)[2][2][4][2], const Unit& u, int wr, int wc, int fr, int fq) const {
        asm volatile("" : "+v"(fr), "+v"(fq));
        const int row0 = u.pm * BM + wr * 64 + fr, col0 = u.pn * BM + wc * 32 + fq * 8;
#pragma unroll
        for (int ai = 0; ai < 2; ++ai)
#pragma unroll
            for (int m = 0; m < 4; ++m) { const size_t row = row0 + ai * 128 + m * 16; float sp = 0.f;
#pragma unroll
                for (int bj = 0; bj < 2; ++bj) { const size_t off = row * DM + col0 + bj * 128;
                    const f32x4 v0 = *(const f32x4*)(base + off) + acc[ai][bj][m][0], v1 = *(const f32x4*)(base + off + 4) + acc[ai][bj][m][1];
                    *(f32x4*)(out + off) = v0; *(f32x4*)(out + off + 4) = v1;
                    if (BF) *(u32x4*)(xb + off) = pack8(v0, v1);
                    sp += (v0[0] * v0[0] + v0[1] * v0[1]) + (v0[2] * v0[2] + v0[3] * v0[3]) + (v1[0] * v1[0] + v1[1] * v1[1]) + (v1[2] * v1[2] + v1[3] * v1[3]); }
                sp += __shfl_xor(sp, 16); sp += __shfl_xor(sp, 32);
                if (fq == 0) ss[row * 16 + u.pn * 4 + wc] = sp; }
    }
};
struct EpiUp {
    static constexpr bool PERM = true, AFTER_DRAIN = false;
    const float* ss; bf16* hm;
    __device__ __forceinline__ void operator()(const f32x4 (&acc)[2][2][4][2], const Unit& u, int wr, int wc, int fr, int fq) const {
        asm volatile("" : "+v"(fr), "+v"(fq));
        const int row0 = u.pm * BM + wr * 64 + fr, col0 = u.pn * 128 + wc * 32 + fq * 8;
#pragma unroll
        for (int ai = 0; ai < 2; ++ai)
#pragma unroll
            for (int m = 0; m < 4; ++m) { const size_t row = row0 + ai * 128 + m * 16; const f32x4* sp = (const f32x4*)(ss + row * 16);
                const f32x4 s4 = (sp[0] + sp[1]) + (sp[2] + sp[3]); const float r2 = rsqrtf(((s4[0] + s4[1]) + (s4[2] + s4[3])) * (1.f / DM) + EPS);
                f32x4 g0 = acc[ai][0][m][0] * r2, g1 = acc[ai][0][m][1] * r2; const f32x4 u0 = acc[ai][1][m][0] * r2, u1 = acc[ai][1][m][1] * r2;
#pragma unroll
                for (int i = 0; i < 4; ++i) { g0[i] = fast_silu(g0[i]) * u0[i]; g1[i] = fast_silu(g1[i]) * u1[i]; }
                *(u32x4*)(hm + row * DFF + col0) = pack8(g0, g1); }
    }
};

template <class Epi, class Sched, bool ALIGN_EPI = false, bool SP2 = false>
__device__ __forceinline__ void gemm_phase(PG8_LAS unsigned char* lds, const Gemm g, const Sched& S, const Epi& E) {
    const int tid = threadIdx.x, wid = __builtin_amdgcn_readfirstlane(tid >> 6), lane = tid & 63, wr = wid >> 2, wc = wid & 3, fr = lane & 15, fq = lane >> 4;
    const int K = g.K, nt = K / BK;
    unsigned voffA[2], voffB[2];
#pragma unroll
    for (int i = 0; i < 2; ++i) { int R, C; stage_rc(tid * 16 + i * 8192, R, C); const int Rb = Epi::PERM ? ((R & ~31) + perm32(R & 31)) : R;
        voffA[i] = (unsigned)(R * K + C) * 2u; voffB[i] = (unsigned)(Rb * K + C) * 2u; }
    const size_t kstep = (size_t)(BK * 2);
    const size_t hstep = (size_t)HALF * K * 2;
    const size_t tstep = 2 * hstep;
    const unsigned ldsw = (unsigned)wid * 1024u;
    const int aoff = lds_byte(wr * 64 + fr, fq * 8), boff = lds_byte(wc * 32 + fr, fq * 8);
#define PG8_SA(b, h) (((b) * 2 + (h)) * HTB)
#define PG8_SB(b, h) ((4 + (b) * 2 + (h)) * HTB)
#define PG8_STAGE(bufoff, gbase, voff) do { _Pragma("unroll") for (int _i = 0; _i < 2; ++_i) \
        __builtin_amdgcn_global_load_lds((const unsigned*)((const char*)(gbase) + (voff)[_i]), (PG8_LAS unsigned*)(lds + (bufoff) + ldsw + _i * 8192), 16, 0, 0); } while (0)
#define PG8_LDA(dst, b, h) do { _Pragma("unroll") for (int m = 0; m < 4; ++m) _Pragma("unroll") for (int k = 0; k < 2; ++k) dst[m][k] = *(const PG8_LAS bf16x8*)(lds + PG8_SA(b, h) + aoff + m * 2048 + k * 1024); } while (0)
#define PG8_LDB(dst, b, h) do { _Pragma("unroll") for (int n = 0; n < 2; ++n) _Pragma("unroll") for (int k = 0; k < 2; ++k) dst[n][k] = *(const PG8_LAS bf16x8*)(lds + PG8_SB(b, h) + boff + n * 2048 + k * 1024); } while (0)
#define PG8_MMA(ai, bj, At, Bt) do { __builtin_amdgcn_s_setprio(1); _Pragma("unroll") for (int m = 0; m < 4; ++m) _Pragma("unroll") for (int n = 0; n < 2; ++n) _Pragma("unroll") for (int k = 0; k < 2; ++k) \
        acc[ai][bj][m][n] = __builtin_amdgcn_mfma_f32_16x16x32_bf16(Bt[n][k], At[m][k], acc[ai][bj][m][n], 0, 0, 0); __builtin_amdgcn_s_setprio(0); } while (0)
#define PG8_WAIT_V(n) asm volatile("s_waitcnt vmcnt(" #n ")" ::: "memory")
#define PG8_WAIT_L(n) asm volatile("s_waitcnt lgkmcnt(" #n ")" ::: "memory")
#define PG8_BAR __builtin_amdgcn_s_barrier()
#define PG8_SCHED __builtin_amdgcn_sched_barrier(0)
    Unit cur, nxt; int ui = 0;
    if (!S.next(0, cur)) return;
    f32x4 acc[2][2][4][2];
#pragma unroll
    for (int a = 0; a < 2; ++a)
#pragma unroll
        for (int b = 0; b < 2; ++b)
#pragma unroll
            for (int m = 0; m < 4; ++m)
#pragma unroll
                for (int n = 0; n < 2; ++n) acc[a][b][m][n] = (f32x4){0.f, 0.f, 0.f, 0.f};
    bf16x8 At[4][2], B0[2][2], B1[2][2];
    const char* cA = (const char*)g.A + (size_t)cur.pm * tstep; const char* cB = (const char*)g.Bt + (size_t)cur.pn * tstep;
    S.a_ready(cur);
    if constexpr (SP2) {
        PG8_STAGE(PG8_SB(0, 0), cB, voffB); PG8_STAGE(PG8_SB(0, 1), cB + hstep, voffB); PG8_STAGE(PG8_SA(0, 0), cA, voffA); PG8_STAGE(PG8_SA(0, 1), cA + hstep, voffA);
        if (wr == 1) PG8_BAR;
        PG8_WAIT_V(2); PG8_BAR;
        PG8_STAGE(PG8_SB(1, 0), cB + kstep, voffB); PG8_STAGE(PG8_SA(1, 0), cA + kstep, voffA); PG8_STAGE(PG8_SB(1, 1), cB + hstep + kstep, voffB);
        PG8_WAIT_V(6); PG8_BAR;
    } else {
        PG8_STAGE(PG8_SB(0, 0), cB, voffB); PG8_STAGE(PG8_SA(0, 0), cA, voffA); PG8_STAGE(PG8_SB(0, 1), cB + hstep, voffB); PG8_STAGE(PG8_SA(0, 1), cA + hstep, voffA);
        if (wr == 1) PG8_BAR;
        PG8_WAIT_V(4); PG8_BAR;
        PG8_STAGE(PG8_SB(1, 0), cB + kstep, voffB); PG8_STAGE(PG8_SA(1, 0), cA + kstep, voffA); PG8_STAGE(PG8_SB(1, 1), cB + hstep + kstep, voffB);
        PG8_WAIT_V(6); PG8_BAR;
    }
    for (;;) {
        const bool has_next = S.next(ui + 1, nxt);
        const char* nA = has_next ? (const char*)g.A + (size_t)nxt.pm * tstep : cA; const char* nB = has_next ? (const char*)g.Bt + (size_t)nxt.pn * tstep : cB;
        for (int t = 0; t < nt; t += 2) {
            const bool last = (t == nt - 2);
            const char* a1 = cA + (size_t)(t + 1) * kstep;
            const char* a2 = last ? nA : cA + (size_t)(t + 2) * kstep; const char* b2 = last ? nB : cB + (size_t)(t + 2) * kstep;
            const char* a3 = a2 + kstep; const char* b3 = b2 + kstep;
            if (last && has_next) S.a_ready(nxt);
            if constexpr (SP2) {
            PG8_LDB(B0, 0, 0); PG8_LDB(B1, 0, 1); PG8_SCHED; PG8_LDA(At, 0, 0); PG8_STAGE(PG8_SA(1, 1), a1 + hstep, voffA);
            PG8_WAIT_V(8); PG8_WAIT_L(0); PG8_BAR; PG8_MMA(0, 0, At, B0); PG8_MMA(0, 1, At, B1); PG8_BAR; PG8_SCHED;
            PG8_LDA(At, 0, 1); PG8_STAGE(PG8_SB(0, 0), b2, voffB); PG8_STAGE(PG8_SB(0, 1), b2 + hstep, voffB); PG8_STAGE(PG8_SA(0, 0), a2, voffA);
            PG8_WAIT_V(8); PG8_WAIT_L(0); PG8_BAR; PG8_MMA(1, 0, At, B0); PG8_MMA(1, 1, At, B1); PG8_BAR; PG8_SCHED;
            PG8_LDB(B0, 1, 0); PG8_LDB(B1, 1, 1); PG8_SCHED; PG8_LDA(At, 1, 0); PG8_STAGE(PG8_SA(0, 1), a2 + hstep, voffA);
            PG8_WAIT_V(8); PG8_WAIT_L(0); PG8_BAR; PG8_MMA(0, 0, At, B0); PG8_MMA(0, 1, At, B1); PG8_BAR; PG8_SCHED;
            PG8_LDA(At, 1, 1); PG8_STAGE(PG8_SB(1, 0), b3, voffB); PG8_STAGE(PG8_SB(1, 1), b3 + hstep, voffB); PG8_STAGE(PG8_SA(1, 0), a3, voffA);
            PG8_WAIT_V(8); PG8_WAIT_L(0); PG8_BAR; PG8_MMA(1, 0, At, B0); PG8_MMA(1, 1, At, B1); PG8_BAR; PG8_SCHED;
            } else {
            PG8_LDB(B0, 0, 0); PG8_SCHED; PG8_LDA(At, 0, 0); PG8_STAGE(PG8_SA(1, 1), a1 + hstep, voffA);
            PG8_WAIT_L(8); PG8_BAR; PG8_WAIT_L(0); PG8_MMA(0, 0, At, B0); PG8_BAR; PG8_SCHED;
            PG8_LDB(B1, 0, 1); PG8_STAGE(PG8_SB(0, 0), b2, voffB);
            PG8_BAR; PG8_WAIT_L(0); PG8_MMA(0, 1, At, B1); PG8_BAR;
            PG8_LDA(At, 0, 1); PG8_STAGE(PG8_SA(0, 0), a2, voffA);
            PG8_BAR; PG8_WAIT_L(0); PG8_MMA(1, 0, At, B0); PG8_BAR; PG8_SCHED;
            PG8_STAGE(PG8_SB(0, 1), b2 + hstep, voffB);
            PG8_WAIT_V(6); PG8_BAR; PG8_MMA(1, 1, At, B1); PG8_BAR;
            PG8_LDB(B0, 1, 0); PG8_SCHED; PG8_LDA(At, 1, 0); PG8_STAGE(PG8_SA(0, 1), a2 + hstep, voffA);
            PG8_WAIT_L(8); PG8_BAR; PG8_WAIT_L(0); PG8_MMA(0, 0, At, B0); PG8_BAR; PG8_SCHED;
            PG8_LDB(B1, 1, 1); PG8_STAGE(PG8_SB(1, 0), b3, voffB);
            PG8_BAR; PG8_WAIT_L(0); PG8_MMA(0, 1, At, B1); PG8_BAR;
            PG8_LDA(At, 1, 1); PG8_STAGE(PG8_SA(1, 0), a3, voffA);
            PG8_BAR; PG8_WAIT_L(0); PG8_MMA(1, 0, At, B0); PG8_BAR; PG8_SCHED;
            PG8_STAGE(PG8_SB(1, 1), b3 + hstep, voffB);
            PG8_WAIT_V(6); PG8_BAR; PG8_MMA(1, 1, At, B1); PG8_BAR;
            }
        }
        if constexpr (ALIGN_EPI) { if (wr == 0) PG8_BAR; }
        if constexpr (!Epi::AFTER_DRAIN) { E(acc, cur, wr, wc, fr, fq); S.done(cur); }
        if (!has_next) break;
#pragma unroll
        for (int a = 0; a < 2; ++a)
#pragma unroll
            for (int b = 0; b < 2; ++b)
#pragma unroll
                for (int m = 0; m < 4; ++m)
#pragma unroll
                    for (int n = 0; n < 2; ++n) acc[a][b][m][n] = (f32x4){0.f, 0.f, 0.f, 0.f};
        cur = nxt; cA = nA; cB = nB; ++ui;
        if constexpr (ALIGN_EPI) { if (wr == 1) PG8_BAR; }
    }
    PG8_WAIT_V(0);
    if constexpr (!ALIGN_EPI) { if (wr == 0) PG8_BAR; }
    PG8_BAR;
    if constexpr (Epi::AFTER_DRAIN) { E.fused(acc, cur, wr, wc, fr, fq, lds, wid, lane); S.done(cur); }
#undef PG8_SA
#undef PG8_SB
#undef PG8_STAGE
#undef PG8_LDA
#undef PG8_LDB
#undef PG8_MMA
#undef PG8_WAIT_V
#undef PG8_WAIT_L
#undef PG8_BAR
#undef PG8_SCHED
}
}

#define LAS __attribute__((address_space(3)))
#define XB_TMO      128
#define XB_XCNT(j)  (256  + 64 * (j))
#define XB_XSUB(j)  (1280 + 64 * (j))
#define XB_XGEN(j)  (2304 + 64 * (j))
#define XB_TOP      3328
#define XB_TOPGEN   3392
#define XCD_BAR_WORDS 3456
#define XB_SPIN_CAP (1u << 18)

__device__ __forceinline__ unsigned xb_ld(unsigned* p)              { return __hip_atomic_load(p, __ATOMIC_RELAXED, __HIP_MEMORY_SCOPE_AGENT); }
__device__ __forceinline__ unsigned xb_add(unsigned* p, unsigned v) { return __hip_atomic_fetch_add(p, v, __ATOMIC_RELAXED, __HIP_MEMORY_SCOPE_AGENT); }
__device__ __forceinline__ unsigned xb_xcc_id() { return (unsigned)__builtin_amdgcn_s_getreg((3 << 11) | 20) & 0xFu; }
#define XB_SPIN(cond, bar) do { unsigned _sp = 0; while (cond) { __builtin_amdgcn_s_sleep(1); \
    if ((++_sp & 255u) == 0u) { if (xb_ld(&(bar)[XB_TMO])) break; if (_sp > XB_SPIN_CAP) { atomicAdd(&(bar)[XB_TMO], 1u); break; } } } } while (0)

struct XcdBarrier {
    unsigned* bar; unsigned x;
    volatile LAS unsigned* st;
};

__device__ __forceinline__ XcdBarrier xcd_barrier_post(unsigned* bar, volatile LAS unsigned* st) {
    XcdBarrier b; b.bar = bar; b.x = xb_xcc_id(); b.st = st;
    if (threadIdx.x == 0) (void)xb_add(&bar[XB_XCNT(b.x)], 1u);
    return b;
}
__device__ __forceinline__ void xcd_barrier_complete(unsigned* bar, unsigned x, unsigned& nloc, unsigned& nx) {
    const unsigned G = gridDim.x * gridDim.y * gridDim.z;
    unsigned sum, cnt, mine, sp = 0u;
    for (;;) {
        sum = 0u; cnt = 0u; mine = 0u;
#pragma unroll
        for (unsigned j = 0; j < 16; ++j) { const unsigned c = xb_ld(&bar[XB_XCNT(j)]); sum += c; cnt += (c > 0u) ? 1u : 0u; mine = (j == x) ? c : mine; }
        if (sum == G) break;
        __builtin_amdgcn_s_sleep(1);
        if ((++sp & 255u) == 0u) { if (xb_ld(&bar[XB_TMO])) break; if (sp > XB_SPIN_CAP) { atomicAdd(&bar[XB_TMO], 1u); break; } }
    }
    nloc = mine > 0u ? mine : 1u; nx = cnt > 0u ? cnt : 1u;
}

__device__ __forceinline__ void xcd_barrier(const XcdBarrier& b) {
    asm volatile("s_waitcnt vmcnt(0)" ::: "memory");
    __syncthreads();
    if (threadIdx.x == 0) {
        unsigned* bar = b.bar;
        __builtin_amdgcn_s_waitcnt(0);
        unsigned nloc = b.st[0], nx = b.st[1];
        if (nloc == 0u) { xcd_barrier_complete(bar, b.x, nloc, nx); b.st[0] = nloc; b.st[1] = nx; }
        const unsigned old = xb_add(&bar[XB_XSUB(b.x)], 1u);
        const unsigned gen = old / nloc;
        if (old + 1u == (gen + 1u) * nloc) {
            __builtin_amdgcn_fence(__ATOMIC_RELEASE, "agent");
            asm volatile("s_waitcnt vmcnt(0)" ::: "memory");
            const unsigned og = xb_add(&bar[XB_TOP], 1u);
            const unsigned tg = og / nx;
            if (og + 1u == (tg + 1u) * nx) xb_add(&bar[XB_TOPGEN], 1u);
            else XB_SPIN(xb_ld(&bar[XB_TOPGEN]) == tg, bar);
            __builtin_amdgcn_fence(__ATOMIC_ACQUIRE, "agent");
            xb_add(&bar[XB_XGEN(b.x)], 1u);
            asm volatile("s_waitcnt vmcnt(0)" ::: "memory");
        } else {
            XB_SPIN(xb_ld(&bar[XB_XGEN(b.x)]) == gen, bar);
            __builtin_amdgcn_fence(__ATOMIC_ACQUIRE, "agent");
            asm volatile("s_waitcnt vmcnt(0)" ::: "memory");
        }
    }
    __syncthreads();
}

namespace mb {
constexpr int D = 128; constexpr float THR = 8.f; constexpr bool WSKIP = false;
typedef short bf16x8 __attribute__((ext_vector_type(8)));
typedef short s16x4 __attribute__((ext_vector_type(4)));
typedef float f32x16 __attribute__((ext_vector_type(16)));
typedef float f32x4 __attribute__((ext_vector_type(4)));
typedef unsigned u32x4 __attribute__((ext_vector_type(4)));
template <class A, class Bt> struct same_t { static constexpr bool v = false; };
template <class A> struct same_t<A, A> { static constexpr bool v = true; };
constexpr float SCALE = 0.08838834764831845f;
constexpr int NW = 8, QBLK = 32, KVBLK = 64, QB = NW * QBLK;
constexpr int SHM_V = KVBLK * D * 2, SHM_K = KVBLK * D * 2;
constexpr int ATT_LDS_BYTES = 2 * SHM_V + 2 * SHM_K + NW * 64 * 4;

#define KSWZ(row, colB) ((row) * 256 + ((colB) ^ (((row) & 7) << 4)))
#define SBAR() __builtin_amdgcn_sched_barrier(0)
__device__ __forceinline__ int v_st(int k, int c) { const int kk = (k & ~0xC) | ((k & 4) << 1) | ((k & 8) >> 1); return ((kk >> 3) * 4 + (c >> 5)) * 512 + ((kk & 7) * 32 + (c & 31)) * 2; }
__device__ __forceinline__ int v_rd_base(int lane) { return ((lane & 3) << 3) | (((lane >> 2) & 3) << 6) | (((lane >> 4) & 1) << 5) | (((lane >> 5) & 1) << 8); }
constexpr int v_rd_off(int d0, int ks, int half) { return d0 * 512 + ks * 4096 + half * 2048; }
__device__ __forceinline__ int crow(int r, int hi) { return (r & 3) + 8 * (r >> 2) + 4 * hi; }
__device__ __forceinline__ unsigned cvtpk(float lo, float hi) {
    unsigned r; asm volatile("v_cvt_pk_bf16_f32 %0, %1, %2" : "=v"(r) : "v"(lo), "v"(hi)); return r;
}
__device__ __forceinline__ bf16x8 pack8(f32x4 a, f32x4 b) {
    u32x4 w = {cvtpk(a[0], a[1]), cvtpk(a[2], a[3]), cvtpk(b[0], b[1]), cvtpk(b[2], b[3])};
    return *reinterpret_cast<bf16x8*>(&w);
}
template <class T> __device__ __forceinline__ bf16x8 load8(const T* p) {
    if constexpr (same_t<T, float>::v) { return pack8(*(const f32x4*)p, *(const f32x4*)(p + 4)); }
    else { return *reinterpret_cast<const bf16x8*>(p); }
}
__device__ __forceinline__ void mask_tile(f32x16& p0, f32x16& p1, int dq, unsigned W) {
    const float NEG = -__builtin_inff();
#pragma unroll
    for (int r = 0; r < 16; ++r) {
        const int c = (r & 3) + 8 * (r >> 2);
        if ((unsigned)(dq - c) >= W) p0[r] = NEG;
        if ((unsigned)(dq - c - 32) >= W) p1[r] = NEG;
    }
}
__device__ __forceinline__ void blk_mask(f32x16& p0, f32x16& p1, unsigned keep) {
    const float NEG = -__builtin_inff();
#pragma unroll
    for (int r = 0; r < 16; ++r) { p0[r] = keep ? p0[r] : NEG; p1[r] = keep ? p1[r] : NEG; }
}
__device__ __forceinline__ void partialSM(f32x16& p0, f32x16& p1, float& m_reg, float& mn, float& alpha) {
    float pmax = p0[0]; for (int r = 1; r < 16; ++r) pmax = fmaxf(pmax, p0[r]); for (int r = 0; r < 16; ++r) pmax = fmaxf(pmax, p1[r]);
    { auto rr = __builtin_amdgcn_permlane32_swap(__float_as_uint(pmax), __float_as_uint(pmax), false, false);
      pmax = fmaxf(__uint_as_float(rr[0]), __uint_as_float(rr[1])); }
    constexpr float C2 = 1.4426950408889634f * SCALE;
    if (__builtin_expect(__all((pmax - m_reg) * SCALE <= THR), 1)) { mn = m_reg; alpha = 1.f; }
    else { mn = fmaxf(m_reg, pmax); alpha = __builtin_amdgcn_exp2f((m_reg - mn) * C2); m_reg = mn; }
    const float mnL = -mn * C2;
    for (int r = 0; r < 16; ++r) p0[r] = fmaf(p0[r], C2, mnL); for (int r = 0; r < 16; ++r) p1[r] = fmaf(p1[r], C2, mnL);
    for (int r = 0; r < 16; ++r) p0[r] = __builtin_amdgcn_exp2f(p0[r]);
}
__device__ __forceinline__ void finishSM(f32x16& p0, f32x16& p1, float alpha, float& l_reg, bf16x8& pa0, bf16x8& pa1, bf16x8& pa2, bf16x8& pa3) {
    for (int r = 0; r < 16; ++r) p1[r] = __builtin_amdgcn_exp2f(p1[r]);
    float ps = 0; for (int r = 0; r < 16; ++r) ps += p0[r]; for (int r = 0; r < 16; ++r) ps += p1[r];
    { auto rr = __builtin_amdgcn_permlane32_swap(__float_as_uint(ps), __float_as_uint(ps), false, false);
      ps = __uint_as_float(rr[0]) + __uint_as_float(rr[1]); }
    l_reg = l_reg * alpha + ps;
#define PK4(P, B_, OUT) do { unsigned a0 = cvtpk(P[B_+0], P[B_+1]), a1 = cvtpk(P[B_+2], P[B_+3]);                          \
        unsigned b0 = cvtpk(P[B_+4], P[B_+5]), b1 = cvtpk(P[B_+6], P[B_+7]);                                             \
        auto r0 = __builtin_amdgcn_permlane32_swap(a0, b0, false, false); auto r1 = __builtin_amdgcn_permlane32_swap(a1, b1, false, false); \
        u32x4 w = {r0[0], r1[0], r0[1], r1[1]}; OUT = *reinterpret_cast<bf16x8*>(&w); } while (0)
    PK4(p0, 0, pa0); PK4(p0, 8, pa1); PK4(p1, 0, pa2); PK4(p1, 8, pa3);
#undef PK4
}
template <int KB, bool SK>
__device__ __forceinline__ void qkt(f32x16& p0, f32x16& p1, const char* K_lds, int r32, int hi, const bf16x8* qr, bool act) {
    if (SK && !act) { const float NEG = -__builtin_inff();
#pragma unroll
        for (int r = 0; r < 16; ++r) { p0[r] = NEG; p1[r] = NEG; } return; }
    p0 = f32x16{}; p1 = f32x16{};
    const char* kb[4];
#pragma unroll
    for (int dd = 0; dd < 4; ++dd) kb[dd] = K_lds + KB * SHM_K + KSWZ(r32, (dd * 16 + hi * 8) * 2);
#pragma unroll
    for (int d0 = 0; d0 < 8; ++d0) { const char* a = kb[d0 & 3] + (d0 >> 2) * 128;
        bf16x8 b0 = *reinterpret_cast<const bf16x8*>(a);
        bf16x8 b1 = *reinterpret_cast<const bf16x8*>(a + 32 * 256);
        p0 = __builtin_amdgcn_mfma_f32_32x32x16_bf16(b0, qr[d0], p0, 0, 0, 0);
        p1 = __builtin_amdgcn_mfma_f32_32x32x16_bf16(b1, qr[d0], p1, 0, 0, 0); }
}
template <int VB, bool SK>
__device__ __forceinline__ void pv_tile(f32x16* o, int vb0, bf16x8 pa0, bf16x8 pa1, bf16x8 pa2, bf16x8 pa3, bool act) {
    if (SK && !act) return;
#define TRRD(dst, off) asm volatile("ds_read_b64_tr_b16 %0, %1 offset:%2" : "=&v"(dst) : "v"(vb0), "i"(off) : "memory")
#define PV_D0(d0) do { s16x4 l0, l1, l2, l3, h0, h1, h2, h3; constexpr int b_ = VB * SHM_V + v_rd_off(d0, 0, 0);     \
        TRRD(l0, b_); TRRD(h0, b_ + 2048); TRRD(l1, b_ + 4096); TRRD(h1, b_ + 6144); TRRD(l2, b_ + 8192); TRRD(h2, b_ + 10240); TRRD(l3, b_ + 12288); TRRD(h3, b_ + 14336); \
        asm volatile("s_waitcnt lgkmcnt(0)" ::: "memory"); SBAR();                 \
        o[d0] = __builtin_amdgcn_mfma_f32_32x32x16_bf16(pa0, (bf16x8){l0[0], l0[1], l0[2], l0[3], h0[0], h0[1], h0[2], h0[3]}, o[d0], 0, 0, 0);   \
        o[d0] = __builtin_amdgcn_mfma_f32_32x32x16_bf16(pa1, (bf16x8){l1[0], l1[1], l1[2], l1[3], h1[0], h1[1], h1[2], h1[3]}, o[d0], 0, 0, 0);   \
        o[d0] = __builtin_amdgcn_mfma_f32_32x32x16_bf16(pa2, (bf16x8){l2[0], l2[1], l2[2], l2[3], h2[0], h2[1], h2[2], h2[3]}, o[d0], 0, 0, 0);   \
        o[d0] = __builtin_amdgcn_mfma_f32_32x32x16_bf16(pa3, (bf16x8){l3[0], l3[1], l3[2], l3[3], h3[0], h3[1], h3[2], h3[3]}, o[d0], 0, 0, 0); } while (0)
    PV_D0(0); PV_D0(1); PV_D0(2); PV_D0(3);
#undef PV_D0
#undef TRRD
}

template <class TIn, class TOut> struct BlockRef { const TIn* Q; const TIn* K; const TIn* V; TOut* O; int P0; int bh; };
template <class TIn> struct Seam {
    bf16x8 qr[8];
    bf16x8 st_v0, st_v1, st_k0, st_k1; f32x4 sf0, sf1, sf2, sf3;
    f32x4 tq[16];
};
__device__ __forceinline__ int swa_jlo(int P0, int W) { const int lowk = P0 - W + 1; return lowk > 0 ? lowk / KVBLK : 0; }
#define ROW(p, k0, rr) ((p) + (size_t)((k0) + (rr)) * D + sc)
#define VMW() asm volatile("s_waitcnt vmcnt(0)" ::: "memory")
#define VMWN(n) asm volatile("s_waitcnt vmcnt(%0)" :: "i"(n) : "memory")
#define SLOAD_H(Kp, Vp, k0) do { S.st_v0 = load8<TIn>(ROW(Vp, k0, sr)); S.st_v1 = load8<TIn>(ROW(Vp, k0, 32 + sr));              \
                         S.st_k0 = load8<TIn>(ROW(Kp, k0, sr)); S.st_k1 = load8<TIn>(ROW(Kp, k0, 32 + sr)); } while (0)
#define SWRITE_HK(bf) do { *(bf16x8*)(K_lds + (bf) * SHM_K + kws) = S.st_k0; *(bf16x8*)(K_lds + (bf) * SHM_K + kws + 32 * 256) = S.st_k1; } while (0)
#define SWRITE_HV(bf) do { *(bf16x8*)(V_lds + (bf) * SHM_V + vst0) = S.st_v0; *(bf16x8*)(V_lds + (bf) * SHM_V + vst1) = S.st_v1; } while (0)
#define SWRITE_H(bf) do { SWRITE_HV(bf); SWRITE_HK(bf); } while (0)
#define SLOAD_F(p, k0) do { S.sf0 = *(const f32x4*)ROW(p, k0, sr); S.sf1 = *(const f32x4*)(ROW(p, k0, sr) + 4);                \
                            S.sf2 = *(const f32x4*)ROW(p, k0, 32 + sr); S.sf3 = *(const f32x4*)(ROW(p, k0, 32 + sr) + 4); } while (0)
#define SWRITE_KF(bf) do { *(bf16x8*)(K_lds + (bf) * SHM_K + kws) = pack8(S.sf0, S.sf1); *(bf16x8*)(K_lds + (bf) * SHM_K + kws + 32 * 256) = pack8(S.sf2, S.sf3); } while (0)
#define SWRITE_VF(bf) do { *(bf16x8*)(V_lds + (bf) * SHM_V + vst0) = pack8(S.sf0, S.sf1); *(bf16x8*)(V_lds + (bf) * SHM_V + vst1) = pack8(S.sf2, S.sf3); } while (0)
template <class TIn, class TOut>
__device__ __forceinline__ void causal_swa_prime(const BlockRef<TIn, TOut>& cur, int W, char* lds, Seam<TIn>& S) {
    constexpr bool F32 = same_t<TIn, float>::v;
    const int tid = threadIdx.x, wid = __builtin_amdgcn_readfirstlane(tid >> 6), lane = tid & 63, r32 = lane & 31, hi = lane >> 5;
    const int sr = tid >> 4, sc = (tid & 15) * 8, kws = KSWZ(sr, sc * 2); char* K_lds = lds + 2 * SHM_V;
    const int kb0 = swa_jlo(cur.P0, W) * KVBLK;
    for (int d0 = 0; d0 < 8; ++d0) S.qr[d0] = load8<TIn>(cur.Q + (size_t)(wid * QBLK + r32) * D + d0 * 16 + hi * 8);
    if constexpr (F32) { SLOAD_F((const float*)cur.K, kb0); VMW(); SWRITE_KF(0); SBAR(); SLOAD_F((const float*)cur.V, kb0); }
    else { SLOAD_H(cur.K, cur.V, kb0); VMW(); SWRITE_HK(0); }
    __syncthreads();
}
template <class TIn, class TOut>
__device__ __forceinline__ void causal_swa_block(const BlockRef<TIn, TOut>& cur, const BlockRef<TIn, TOut>& nxt, int skv, int W, char* lds, Seam<TIn>& S, const float* ksum) {
    constexpr bool F32 = same_t<TIn, float>::v;
    const int tid = threadIdx.x, wid = __builtin_amdgcn_readfirstlane(tid >> 6), lane = tid & 63, r32 = lane & 31, hi = lane >> 5;
    const int j_lo = swa_jlo(cur.P0, W);
    const int qb = cur.P0 >> 8; unsigned selm = 0xffu;
    if (qb > 3) {
        f32x16 g = f32x16{};
        const float* kp = ksum + ((size_t)((cur.bh >> 2) * 8 + (r32 & 7)) * 2) * 512 + (cur.bh & 3) * 128 + hi * 8;
#pragma unroll
        for (int d0 = 0; d0 < 8; ++d0) { const f32x4 a0 = *(const f32x4*)(kp + d0 * 16) + *(const f32x4*)(kp + 512 + d0 * 16), a1 = *(const f32x4*)(kp + d0 * 16 + 4) + *(const f32x4*)(kp + 512 + d0 * 16 + 4);
            u32x4 wh = {cvtpk(a0[0], a0[1]), cvtpk(a0[2], a0[3]), cvtpk(a1[0], a1[1]), cvtpk(a1[2], a1[3])};
            f32x4 r0 = {a0[0] - __uint_as_float(wh[0] << 16), a0[1] - __uint_as_float(wh[0] & 0xffff0000u), a0[2] - __uint_as_float(wh[1] << 16), a0[3] - __uint_as_float(wh[1] & 0xffff0000u)};
            f32x4 r1 = {a1[0] - __uint_as_float(wh[2] << 16), a1[1] - __uint_as_float(wh[2] & 0xffff0000u), a1[2] - __uint_as_float(wh[3] << 16), a1[3] - __uint_as_float(wh[3] & 0xffff0000u)};
            u32x4 wl = {cvtpk(r0[0], r0[1]), cvtpk(r0[2], r0[3]), cvtpk(r1[0], r1[1]), cvtpk(r1[2], r1[3])};
            g = __builtin_amdgcn_mfma_f32_32x32x16_bf16(*reinterpret_cast<bf16x8*>(&wh), S.qr[d0], g, 0, 0, 0);
            g = __builtin_amdgcn_mfma_f32_32x32x16_bf16(*reinterpret_cast<bf16x8*>(&wl), S.qr[d0], g, 0, 0, 0); }
        float gv[8];
#pragma unroll
        for (int j = 0; j < 4; ++j) { const float own = g[j], oth = __shfl_xor(own, 32); gv[j] = hi ? oth : own; gv[j + 4] = hi ? own : oth; }
        selm = 0u;
#pragma unroll
        for (int j = 0; j < 8; ++j) { int rank = 0;
#pragma unroll
            for (int k = 0; k < 8; ++k) if (k < qb && (gv[k] > gv[j] || (gv[k] == gv[j] && k < j))) ++rank;
            if (j < qb && rank < 3) selm |= 1u << j; }
    }
    int j_hi = (cur.P0 + QB - 1) / KVBLK + 1; if (j_hi > skv / KVBLK) j_hi = skv / KVBLK;
    const int NT = j_hi - j_lo;
    const int kbn = swa_jlo(nxt.P0, W) * KVBLK;
    const int qlo = cur.P0 + wid * QBLK, qm = qlo + r32 - 4 * hi;
    char* V_lds = lds; char* K_lds = lds + 2 * SHM_V;
    float* ws = (float*)(lds + 2 * SHM_V + 2 * SHM_K) + wid * 64; float* li_l = ws, * al_l = ws + 32;
    float m_reg = -1e30f, l_reg = 0; f32x16 o[4] = {};
    const int sr = tid >> 4, sc = (tid & 15) * 8, vst0 = v_st(sr, sc), vst1 = v_st(32 + sr, sc), kws = KSWZ(sr, sc * 2);
    const int vb0 = (int)(uintptr_t)V_lds + v_rd_base(lane);
    const TIn* Kh = cur.K; const TIn* Vh = cur.V;
#define RESC(a) do { if (__any((a) < 1.f)) { if (hi == 0) al_l[r32] = (a); asm volatile("s_waitcnt lgkmcnt(0)" ::: "memory");              \
                     for (int d_ = 0; d_ < 4; ++d_) for (int r = 0; r < 16; ++r) o[d_][r] *= al_l[crow(r, hi)]; } } while (0)
#define KBASE(t) ((j_lo + (t)) * KVBLK)
#define ACT(t) (KBASE(t) <= qlo + QBLK - 1 && KBASE(t) + KVBLK - 1 >= qlo - W + 1)
#define MASKT(P0_, P1_, t) do { const int kb_ = KBASE(t); if ((!SK || ACT(t)) && (kb_ + KVBLK - 1 > qlo || kb_ <= qlo + QBLK - 1 - W)) mask_tile(P0_, P1_, qm - kb_, (unsigned)W); if (qb > 3 && kb_ < cur.P0) blk_mask(P0_, P1_, (selm >> (kb_ >> 8)) & 1u); } while (0)
    constexpr int NQL = F32 ? 16 : 8;
    constexpr bool SK = WSKIP && !F32;
#define SEAM_K0() do { VMWN(NQL); if constexpr (F32) { SWRITE_KF(0); SBAR(); SLOAD_F((const float*)nxt.V, kbn); } else { SWRITE_HK(0); } SBAR(); } while (0)
    f32x16 pA0, pA1, pB0, pB1; float mnA, mnB, alA, alB; bf16x8 pa0, pa1, pa2, pa3;
    if constexpr (F32) { VMW(); SWRITE_VF(0); SBAR(); } else { SWRITE_HV(0); SBAR(); }
    if (NT > 1) { if constexpr (F32) SLOAD_F((const float*)Kh, KBASE(1)); else SLOAD_H(Kh, Vh, KBASE(1)); }
    SBAR(); qkt<0, SK>(pA0, pA1, K_lds, r32, hi, S.qr, ACT(0));
    if constexpr (F32) { if (NT > 1) { VMW(); SWRITE_KF(1); SBAR(); SLOAD_F((const float*)Vh, KBASE(1)); } }
    MASKT(pA0, pA1, 0); partialSM(pA0, pA1, m_reg, mnA, alA);
    if (NT > 1) { VMW(); if constexpr (F32) { SWRITE_VF(1); SBAR(); if (NT > 2) SLOAD_F((const float*)Kh, KBASE(2)); } else SWRITE_H(1); }
    __syncthreads();
#define HALF_STEP(PX0, PX1, mnX, alX, PY0, PY1, alY, t, KB, VB, SB) do {                                                      \
        SBAR(); qkt<KB, SK>(PX0, PX1, K_lds, r32, hi, S.qr, ACT(t));                                             \
        finishSM(PY0, PY1, alY, l_reg, pa0, pa1, pa2, pa3); SBAR();                                                           \
        if ((t) + 1 < NT) { if constexpr (F32) { VMW(); SWRITE_KF(SB); SBAR(); SLOAD_F((const float*)Vh, KBASE((t) + 1)); }  \
                            else { SLOAD_H(Kh, Vh, KBASE((t) + 1)); } SBAR(); }                                               \
        pv_tile<VB, SK>(o, vb0, pa0, pa1, pa2, pa3, ACT((t) - 1)); MASKT(PX0, PX1, (t)); partialSM(PX0, PX1, m_reg, mnX, alX);                                        \
        __syncthreads();                                                                                                      \
        if ((t) + 1 < NT) { VMW(); if constexpr (F32) { SWRITE_VF(SB); SBAR(); if ((t) + 2 < NT) SLOAD_F((const float*)Kh, KBASE((t) + 2)); } \
                            else { SWRITE_H(SB); } }                                                                          \
        RESC(alX); __syncthreads(); } while (0)
    for (int t = 1; t + 1 < NT; t += 2) {
        HALF_STEP(pB0, pB1, mnB, alB, pA0, pA1, alA, t, 1, 0, 0);
        HALF_STEP(pA0, pA1, mnA, alA, pB0, pB1, alB, t + 1, 0, 1, 1);
    }
    const bool even = (NT & 1) == 0;
    if (even) { SBAR(); qkt<1, SK>(pB0, pB1, K_lds, r32, hi, S.qr, ACT(NT - 1)); SBAR(); }
#define QROW(e) (nxt.Q + (size_t)(wid * QBLK + r32) * D + ((e) >> 1) * 16 + hi * 8 + ((e) & 1) * 4)
    if constexpr (F32) { SLOAD_F((const float*)nxt.K, kbn); SBAR();
#pragma unroll
        for (int e = 0; e < 8; ++e) S.tq[e] = *(const f32x4*)QROW(e); }
    else { SLOAD_H(nxt.K, nxt.V, kbn); SBAR();
#pragma unroll
        for (int d0 = 0; d0 < 8; ++d0) S.qr[d0] = load8<TIn>(nxt.Q + (size_t)(wid * QBLK + r32) * D + d0 * 16 + hi * 8); }
    SBAR();
    finishSM(pA0, pA1, alA, l_reg, pa0, pa1, pa2, pa3); SBAR();
    if constexpr (F32) {
#pragma unroll
        for (int e = 8; e < 16; ++e) S.tq[e] = *(const f32x4*)QROW(e); SBAR(); }
#undef QROW
    pv_tile<0, SK>(o, vb0, pa0, pa1, pa2, pa3, ACT(even ? NT - 2 : NT - 1));
    if (even) { MASKT(pB0, pB1, NT - 1); partialSM(pB0, pB1, m_reg, mnB, alB); __syncthreads(); RESC(alB);
        finishSM(pB0, pB1, alB, l_reg, pa0, pa1, pa2, pa3); SBAR(); pv_tile<1, SK>(o, vb0, pa0, pa1, pa2, pa3, ACT(NT - 1)); }
    SBAR(); SEAM_K0();
    if (hi == 0) li_l[r32] = l_reg; asm volatile("s_waitcnt lgkmcnt(0)" ::: "memory");
    float rli[16];
#pragma unroll
    for (int r = 0; r < 16; ++r) { const float rl = __builtin_amdgcn_rcpf(li_l[crow(r, hi)]);
        float q = 0.f;
#pragma unroll
        for (int d0 = 0; d0 < 4; ++d0) { const float v = o[d0][r] * rl; q += v * v; }
#pragma unroll
        for (int x = 1; x < 32; x <<= 1) q += __shfl_xor(q, x);
        rli[r] = rl * rsqrtf(q * (1.f / 128.f) + 1e-6f); }
    char* Ow = (char*)(cur.O + ((size_t)(cur.bh >> 2) * 2048 + cur.P0 + wid * QBLK) * 1024 + 512 + (cur.bh & 3) * 128);
    unsigned oo = (unsigned)(hi * 4 * 2048 + r32 * 2);
#pragma unroll
    for (int r = 0; r < 16; ++r) {
#pragma unroll
        for (int d0 = 0; d0 < 4; ++d0) { const float v = o[d0][r] * rli[r];
            const float vn = __shfl_xor(v, 1);
            if ((r32 & 1) == 0) *(unsigned*)(Ow + oo + d0 * 64) = cvtpk(v, vn); }
        oo += ((r & 3) == 3) ? 5 * 2048 : 2048; asm volatile("" : "+v"(oo)); }
    if constexpr (F32) {
#pragma unroll
        for (int d0 = 0; d0 < 8; ++d0) S.qr[d0] = pack8(S.tq[2 * d0], S.tq[2 * d0 + 1]); }
    __syncthreads();
#undef RESC
#undef KBASE
#undef ACT
#undef MASKT
#undef SEAM_K0
#undef HALF_STEP
}
#undef ROW
#undef VMW
#undef VMWN
#undef SLOAD_H
#undef SWRITE_HK
#undef SWRITE_HV
#undef SWRITE_H
#undef SLOAD_F
#undef SWRITE_KF
#undef SWRITE_VF

struct Item { int bh, qb0, qb1; };
__device__ __forceinline__ Item decode(int L) { Item it; const int xcd = L & 7, k = L >> 3, gi = k >> 2, x = k & 3; it.bh = gi * 8 + xcd; it.qb0 = x; it.qb1 = 7 - x; return it; }
__device__ __forceinline__ BlockRef<bf16, bf16> mkref(const Item& it, int pass, const bf16* Q, const bf16* K, const bf16* V, bf16* O) {
    const int qb = pass ? it.qb1 : it.qb0; BlockRef<bf16, bf16> r;
    r.Q = Q + ((size_t)it.bh * 2048 + (size_t)qb * QB) * D; r.K = K + (size_t)it.bh * 2048 * D; r.V = V + (size_t)it.bh * 2048 * D; r.O = O; r.P0 = qb * QB; r.bh = it.bh; return r;
}
__device__ __forceinline__ void moba_phase(char* lds, const bf16* Q, const bf16* K, const bf16* V, bf16* O, const float* ksum, int xcd, int k0, int cnt) {
    constexpr int W = 1 << 20;
    if (cnt <= 0) return;
    int kk = k0; Item it = decode(kk * 8 + xcd); int pass = 0;
    BlockRef<bf16, bf16> cur = mkref(it, 0, Q, K, V, O);
    Seam<bf16> S;
    causal_swa_prime<bf16, bf16>(cur, W, lds, S);
    for (;;) {
        const bool more_pass = pass == 0, more_item = kk + 1 < k0 + cnt, last = !more_pass && !more_item;
        Item itn = it; int passn = pass + 1, kn = kk;
        if (!more_pass) { passn = 0; kn = more_item ? kk + 1 : kk; itn = decode(kn * 8 + xcd); }
        const BlockRef<bf16, bf16> nxt = last ? cur : mkref(itn, passn, Q, K, V, O);
        causal_swa_block<bf16, bf16>(cur, nxt, 2048, W, lds, S, ksum);
        if (last) break;
        cur = nxt; it = itn; pass = passn; kk = kn;
    }
}
}

namespace gla {
typedef short bf16x8 __attribute__((ext_vector_type(8)));
typedef short s16x4 __attribute__((ext_vector_type(4)));
typedef float f32x16 __attribute__((ext_vector_type(16)));
typedef float f32x4 __attribute__((ext_vector_type(4)));
typedef unsigned u32x4 __attribute__((ext_vector_type(4)));
typedef unsigned u32x2 __attribute__((ext_vector_type(2)));
constexpr int L_QD = 0, L_KI = 8192, L_KE = 16384, L_V = 24576, L_ST = 40960, L_OST = 73728, L_DEC = 90112, GLA_LDS_BYTES = 90368;
constexpr float LOG2E = 1.4426950408889634f;
__device__ __forceinline__ int swz128(int row, int colB) { return row * 128 + (colB ^ (((row >> 1) & 7) << 4)); }
__device__ __forceinline__ int tr_st(int k, int c, int ncs) { const int kk = (k & ~0xC) | ((k & 4) << 1) | ((k & 8) >> 1); return ((kk >> 3) * ncs + (c >> 5)) * 512 + ((kk & 7) * 32 + (c & 31)) * 2; }
__device__ __forceinline__ int tr_rd_base(int lane) { return ((lane & 3) << 3) | (((lane >> 2) & 3) << 6) | (((lane >> 4) & 1) << 5) | (((lane >> 5) & 1) << 8); }
__device__ __forceinline__ int crow(int r, int hi) { return (r & 3) + 8 * (r >> 2) + 4 * hi; }
typedef float f32x2_t __attribute__((ext_vector_type(2))); typedef __bf16 bf16x2_t __attribute__((ext_vector_type(2)));
__device__ __forceinline__ unsigned cvtpk(float lo, float hi) { f32x2_t v = {lo, hi}; bf16x2_t b = __builtin_convertvector(v, bf16x2_t); return __builtin_bit_cast(unsigned, b); }
__device__ __forceinline__ float bflo(unsigned w) { return __uint_as_float(w << 16); }
__device__ __forceinline__ float bfhi(unsigned w) { return __uint_as_float(w & 0xffff0000u); }
#define GLA_SBAR() __builtin_amdgcn_sched_barrier(0)
#define GLA_TRRD(dst, addr, off) asm volatile("ds_read_b64_tr_b16 %0, %1 offset:%2" : "=&v"(dst) : "v"(addr), "i"(off) : "memory")
#define GLA_FRAG(l, h) (bf16x8){l[0], l[1], l[2], l[3], h[0], h[1], h[2], h[3]}
#define GLA_PK4(P, B_, OUT) do { unsigned a0 = cvtpk(P[B_+0], P[B_+1]), a1 = cvtpk(P[B_+2], P[B_+3]); unsigned b0 = cvtpk(P[B_+4], P[B_+5]), b1 = cvtpk(P[B_+6], P[B_+7]); \
        auto r0 = __builtin_amdgcn_permlane32_swap(a0, b0, false, false); auto r1 = __builtin_amdgcn_permlane32_swap(a1, b1, false, false); \
        u32x4 w = {r0[0], r1[0], r0[1], r1[1]}; OUT = *reinterpret_cast<bf16x8*>(&w); } while (0)

__device__ __forceinline__ void gla_unit(char* lds, int bh, const bf16* GQ, const bf16* GK, const bf16* GV, const float* GB, const bf16* GR, bf16* O) {
    const int tid = threadIdx.x, lane = tid & 63, r32 = lane & 31, hi = lane >> 5; const int wid = __builtin_amdgcn_readfirstlane(tid >> 6), dvt = wid & 3, half = wid >> 2;
    const int sc = tid >> 3, j8 = tid & 7;
    const bf16* qp = GQ + ((size_t)bh * SEQ + sc) * 64 + j8 * 8; const bf16* kp = GK + ((size_t)bh * SEQ + sc) * 64 + j8 * 8;
    const float* bp = GB + ((size_t)bh * SEQ + sc) * 64 + j8 * 8; const float* blp = GB + ((size_t)bh * SEQ + 63) * 64 + j8 * 8;
    const bf16* vp = GV + ((size_t)bh * SEQ + sc) * 128 + j8 * 16;
    const size_t t0 = (size_t)(bh >> 2) * SEQ; const int hcol = (bh & 3) * 128 + j8 * 16;
    const bf16* grp = GR + (t0 + sc) * 512 + hcol; bf16* op = O + (t0 + sc) * DM + hcol;
    const int ldsb = (int)(uintptr_t)lds;
    const int vtr = ldsb + L_V + tr_rd_base(lane) + dvt * 512, ketr = ldsb + L_KE + tr_rd_base(lane) + half * 512;
    const int w_qd = swz128(sc, j8 * 16), w_ke = tr_st(sc, j8 * 8, 2), w_v0 = tr_st(sc, j8 * 16, 4), w_v1 = tr_st(sc, j8 * 16 + 8, 4);
    { u32x4 z = {0u, 0u, 0u, 0u}; *(u32x4*)(lds + L_ST + tid * 32) = z; *(u32x4*)(lds + L_ST + tid * 32 + 16) = z; }
    f32x16 S = f32x16{};
    u32x4 sq = *(const u32x4*)qp, sk = *(const u32x4*)kp, sv0 = *(const u32x4*)vp, sv1 = *(const u32x4*)(vp + 8);
    f32x4 sb0 = *(const f32x4*)bp, sb1 = *(const f32x4*)(bp + 4), sl0 = *(const f32x4*)blp, sl1 = *(const f32x4*)(blp + 4);
    for (int n = 0; n < 32; ++n) {
        const int p = n & 1;
        { float q[8], k[8], b2[8], l2[8];
            q[0] = bflo(sq.x); q[1] = bfhi(sq.x); q[2] = bflo(sq.y); q[3] = bfhi(sq.y); q[4] = bflo(sq.z); q[5] = bfhi(sq.z); q[6] = bflo(sq.w); q[7] = bfhi(sq.w);
            k[0] = bflo(sk.x); k[1] = bfhi(sk.x); k[2] = bflo(sk.y); k[3] = bfhi(sk.y); k[4] = bflo(sk.z); k[5] = bfhi(sk.z); k[6] = bflo(sk.w); k[7] = bfhi(sk.w);
#pragma unroll
            for (int i = 0; i < 4; ++i) { b2[i] = sb0[i] * LOG2E; b2[4 + i] = sb1[i] * LOG2E; l2[i] = sl0[i] * LOG2E; l2[4 + i] = sl1[i] * LOG2E; }
            float qd[8], ki[8], ke[8];
#pragma unroll
            for (int i = 0; i < 8; ++i) { qd[i] = q[i] * 0.125f * __builtin_amdgcn_exp2f(b2[i]); ki[i] = k[i] * __builtin_amdgcn_exp2f(-b2[i]); ke[i] = k[i] * __builtin_amdgcn_exp2f(l2[i] - b2[i]); }
            u32x4 w;
            w.x = cvtpk(qd[0], qd[1]); w.y = cvtpk(qd[2], qd[3]); w.z = cvtpk(qd[4], qd[5]); w.w = cvtpk(qd[6], qd[7]); *(u32x4*)(lds + L_QD + w_qd) = w;
            w.x = cvtpk(ki[0], ki[1]); w.y = cvtpk(ki[2], ki[3]); w.z = cvtpk(ki[4], ki[5]); w.w = cvtpk(ki[6], ki[7]); *(u32x4*)(lds + L_KI + w_qd) = w;
            w.x = cvtpk(ke[0], ke[1]); w.y = cvtpk(ke[2], ke[3]); w.z = cvtpk(ke[4], ke[5]); w.w = cvtpk(ke[6], ke[7]); *(u32x4*)(lds + L_KE + w_ke) = w;
            *(u32x4*)(lds + L_V + w_v0) = sv0; *(u32x4*)(lds + L_V + w_v1) = sv1;
            if (sc == 0) { f32x4 d0, d1;
#pragma unroll
                for (int i = 0; i < 4; ++i) { d0[i] = __builtin_amdgcn_exp2f(l2[i]); d1[i] = __builtin_amdgcn_exp2f(l2[4 + i]); }
                *(f32x4*)(lds + L_DEC + j8 * 32) = d0; *(f32x4*)(lds + L_DEC + j8 * 32 + 16) = d1; } }
        const u32x4 g0 = *(const u32x4*)(grp + (size_t)n * 64 * 512), g1 = *(const u32x4*)(grp + (size_t)n * 64 * 512 + 8);
        if (n + 1 < 32) { const size_t o64 = (size_t)(n + 1) * 64 * 64, o128 = (size_t)(n + 1) * 64 * 128;
            sq = *(const u32x4*)(qp + o64); sk = *(const u32x4*)(kp + o64); sv0 = *(const u32x4*)(vp + o128); sv1 = *(const u32x4*)(vp + o128 + 8);
            sb0 = *(const f32x4*)(bp + o64); sb1 = *(const f32x4*)(bp + o64 + 4); sl0 = *(const f32x4*)(blp + o64); sl1 = *(const f32x4*)(blp + o64 + 4); }
        __syncthreads();
        {
            bf16x8 qf[4];
#pragma unroll
            for (int ks = 0; ks < 4; ++ks) qf[ks] = *(const bf16x8*)(lds + L_QD + swz128(half * 32 + r32, ks * 32 + hi * 16));
            f32x16 X0 = f32x16{}, X1 = f32x16{};
#pragma unroll
            for (int ks = 0; ks < 4; ++ks) X0 = __builtin_amdgcn_mfma_f32_32x32x16_bf16(*(const bf16x8*)(lds + L_KI + swz128(r32, ks * 32 + hi * 16)), qf[ks], X0, 0, 0, 0);
            if (half) {
#pragma unroll
                for (int ks = 0; ks < 4; ++ks) X1 = __builtin_amdgcn_mfma_f32_32x32x16_bf16(*(const bf16x8*)(lds + L_KI + swz128(32 + r32, ks * 32 + hi * 16)), qf[ks], X1, 0, 0, 0);
#pragma unroll
                for (int r = 0; r < 16; ++r) X1[r] = (crow(r, hi) <= r32) ? X1[r] : 0.f;
            } else {
#pragma unroll
                for (int r = 0; r < 16; ++r) X0[r] = (crow(r, hi) <= r32) ? X0[r] : 0.f;
            }
            bf16x8 pa0, pa1, pa2, pa3;
            GLA_PK4(X0, 0, pa0); GLA_PK4(X0, 8, pa1); GLA_PK4(X1, 0, pa2); GLA_PK4(X1, 8, pa3);
            s16x4 vl0, vh0, vl1, vh1, vl2, vh2, vl3, vh3, kl0, kh0, kl1, kh1, kl2, kh2, kl3, kh3;
            GLA_TRRD(vl0, vtr, 0); GLA_TRRD(vh0, vtr, 2048); GLA_TRRD(vl1, vtr, 4096); GLA_TRRD(vh1, vtr, 6144); GLA_TRRD(vl2, vtr, 8192); GLA_TRRD(vh2, vtr, 10240); GLA_TRRD(vl3, vtr, 12288); GLA_TRRD(vh3, vtr, 14336);
            GLA_TRRD(kl0, ketr, 0); GLA_TRRD(kh0, ketr, 1024); GLA_TRRD(kl1, ketr, 2048); GLA_TRRD(kh1, ketr, 3072); GLA_TRRD(kl2, ketr, 4096); GLA_TRRD(kh2, ketr, 5120); GLA_TRRD(kl3, ketr, 6144); GLA_TRRD(kh3, ketr, 7168);
            bf16x8 bs[4];
#pragma unroll
            for (int ks = 0; ks < 4; ++ks) bs[ks] = *(const bf16x8*)(lds + L_ST + p * 16384 + swz128(dvt * 32 + r32, ks * 32 + hi * 16));
            float dec[16];
#pragma unroll
            for (int r = 0; r < 16; ++r) dec[r] = *(const float*)(lds + L_DEC + (half * 32 + crow(r, hi)) * 4);
            asm volatile("s_waitcnt lgkmcnt(0)" ::: "memory"); GLA_SBAR();
            f32x16 o = f32x16{};
            o = __builtin_amdgcn_mfma_f32_32x32x16_bf16(pa0, GLA_FRAG(vl0, vh0), o, 0, 0, 0);
            o = __builtin_amdgcn_mfma_f32_32x32x16_bf16(pa1, GLA_FRAG(vl1, vh1), o, 0, 0, 0);
            if (half) { o = __builtin_amdgcn_mfma_f32_32x32x16_bf16(pa2, GLA_FRAG(vl2, vh2), o, 0, 0, 0); o = __builtin_amdgcn_mfma_f32_32x32x16_bf16(pa3, GLA_FRAG(vl3, vh3), o, 0, 0, 0); }
#pragma unroll
            for (int ks = 0; ks < 4; ++ks) o = __builtin_amdgcn_mfma_f32_32x32x16_bf16(qf[ks], bs[ks], o, 0, 0, 0);
#pragma unroll
            for (int r = 0; r < 16; ++r) S[r] *= dec[r];
            S = __builtin_amdgcn_mfma_f32_32x32x16_bf16(GLA_FRAG(kl0, kh0), GLA_FRAG(vl0, vh0), S, 0, 0, 0);
            S = __builtin_amdgcn_mfma_f32_32x32x16_bf16(GLA_FRAG(kl1, kh1), GLA_FRAG(vl1, vh1), S, 0, 0, 0);
            S = __builtin_amdgcn_mfma_f32_32x32x16_bf16(GLA_FRAG(kl2, kh2), GLA_FRAG(vl2, vh2), S, 0, 0, 0);
            S = __builtin_amdgcn_mfma_f32_32x32x16_bf16(GLA_FRAG(kl3, kh3), GLA_FRAG(vl3, vh3), S, 0, 0, 0);
#pragma unroll
            for (int r = 0; r < 16; ++r) *(unsigned short*)(lds + L_OST + (half * 32 + crow(r, hi)) * 256 + (dvt * 32 + r32) * 2) = (unsigned short)(cvtpk(o[r], 0.f) & 0xffffu);
#pragma unroll
            for (int g = 0; g < 4; ++g) { u32x2 w2; w2.x = cvtpk(S[4 * g], S[4 * g + 1]); w2.y = cvtpk(S[4 * g + 2], S[4 * g + 3]);
                *(u32x2*)(lds + L_ST + (p ^ 1) * 16384 + swz128(dvt * 32 + r32, (half * 32 + 8 * g + 4 * hi) * 2)) = w2; }
        }
        __syncthreads();
        { const u32x4 a = *(const u32x4*)(lds + L_OST + sc * 256 + j8 * 32), b = *(const u32x4*)(lds + L_OST + sc * 256 + j8 * 32 + 16);
            float v[16];
            v[0] = bflo(a.x); v[1] = bfhi(a.x); v[2] = bflo(a.y); v[3] = bfhi(a.y); v[4] = bflo(a.z); v[5] = bfhi(a.z); v[6] = bflo(a.w); v[7] = bfhi(a.w);
            v[8] = bflo(b.x); v[9] = bfhi(b.x); v[10] = bflo(b.y); v[11] = bfhi(b.y); v[12] = bflo(b.z); v[13] = bfhi(b.z); v[14] = bflo(b.w); v[15] = bfhi(b.w);
            float ss = 0.f;
#pragma unroll
            for (int i = 0; i < 16; ++i) ss += v[i] * v[i];
            ss += __shfl_xor(ss, 1); ss += __shfl_xor(ss, 2); ss += __shfl_xor(ss, 4);
            const float rs = rsqrtf(ss * (1.f / 128.f) + EPS);
            float g[16];
            g[0] = bflo(g0.x); g[1] = bfhi(g0.x); g[2] = bflo(g0.y); g[3] = bfhi(g0.y); g[4] = bflo(g0.z); g[5] = bfhi(g0.z); g[6] = bflo(g0.w); g[7] = bfhi(g0.w);
            g[8] = bflo(g1.x); g[9] = bfhi(g1.x); g[10] = bflo(g1.y); g[11] = bfhi(g1.y); g[12] = bflo(g1.z); g[13] = bfhi(g1.z); g[14] = bflo(g1.w); g[15] = bfhi(g1.w);
#pragma unroll
            for (int i = 0; i < 16; ++i) v[i] = v[i] * rs * g[i];
            u32x4 w0, w1;
            w0.x = cvtpk(v[0], v[1]); w0.y = cvtpk(v[2], v[3]); w0.z = cvtpk(v[4], v[5]); w0.w = cvtpk(v[6], v[7]);
            w1.x = cvtpk(v[8], v[9]); w1.y = cvtpk(v[10], v[11]); w1.z = cvtpk(v[12], v[13]); w1.w = cvtpk(v[14], v[15]);
            bf16* orow = op + (size_t)n * 64 * DM; *(u32x4*)orow = w0; *(u32x4*)(orow + 8) = w1; }
    }
    __syncthreads();
}
#undef GLA_SBAR
#undef GLA_TRRD
#undef GLA_FRAG
#undef GLA_PK4
}

constexpr int RING_OFF = 0, RING_BYTES = 131072;
constexpr int LDSCTL_OFF = RING_BYTES, MISC_OFF = LDSCTL_OFF + 320;
constexpr int LDS_BYTES = 147456;
constexpr int NWAVES = 8;
constexpr int CW_TMO = 0, CW_CODE = 1, CW_BAR = 4096;
constexpr int N_PHASES = 7;

struct Args { Ptrs P; int ph_lo, ph_hi, li, pad; };

__device__ __forceinline__ void p6_final(const Ptrs& P, int gw, int NGW, int lane) {
    const float* SS3 = (const float*)(P.ws + WS_SS3);
    for (int m = gw; m < T; m += NGW) {
        const f32x4* sp = (const f32x4*)(SS3 + (size_t)m * 16); const f32x4 s4 = (sp[0] + sp[1]) + (sp[2] + sp[3]);
        const float r = rsqrtf(((s4[0] + s4[1]) + (s4[2] + s4[3])) * (1.f / DM) + EPS);
        f32x4* xr = (f32x4*)(P.out + (size_t)m * DM) + lane; const f32x4* gr = (const f32x4*)P.gf + lane;
#pragma unroll
        for (int j = 0; j < 4; ++j) { f32x4 v = xr[64 * j]; const f32x4 g = gr[64 * j]; v = v * r * g; xr[64 * j] = v; }
    }
}

__global__ void __launch_bounds__(NWAVES * 64, 2) mega_fwd(Args args) {
    extern __shared__ __attribute__((aligned(16))) unsigned char lds[];
    const Ptrs& P = args.P;
    const int tid = threadIdx.x, lane = tid & 63, wave = __builtin_amdgcn_readfirstlane(tid >> 6);
    const int G = gridDim.x; const int bx = blockIdx.x; const int vcu = (G % 8 == 0) ? (bx % 8) * (G / 8) + bx / 8 : bx;
    unsigned char* ws = P.ws;
    unsigned* ctl = (unsigned*)(ws + WS_CTL);
    LAS unsigned char* l3 = (LAS unsigned char*)lds;
    for (int u = tid; u < (LDS_BYTES - LDSCTL_OFF) / 4; u += NWAVES * 64) ((LAS unsigned*)(l3 + LDSCTL_OFF))[u] = 0u;
    __syncthreads();
    XcdBarrier bar = xcd_barrier_post(ctl + CW_BAR + args.li * XCD_BAR_WORDS, (volatile LAS unsigned*)(l3 + MISC_OFF) + 8);
    const int lo = args.ph_lo, hi = args.ph_hi;
#define IN(k) (lo <= (k) && (k) < hi)
#define BOTH(k) (IN(k) && IN((k) + 1))
#define GRID_BAR() xcd_barrier(bar)
    const int gw = vcu * NWAVES + wave, NGW = G * NWAVES;

    if (IN(0)) { p0_prologue(P, (float*)lds, gw, NGW, lane, wave); if (BOTH(0)) GRID_BAR(); }

    if (IN(1)) {
        pg8::Gemm g{(const bf16*)(ws + WS_XB), (const bf16*)(ws + WS_WIN), T, NINP, DM}; pg8::StaticOrder S; S.init(T, NINP, G, (int)blockIdx.x);
        pg8::EpiIn E{ws, P.b_gate};
        pg8::gemm_phase<pg8::EpiIn, pg8::StaticOrder, true, true>(l3 + RING_OFF, g, S, E);
        if (BOTH(1)) GRID_BAR();
    }
    if (IN(2)) {
        const int xcd = bx & 7, gi = bx >> 4; const bool isg = ((bx >> 3) & 1) == 0;
        if (isg) gla::gla_unit((char*)lds + RING_OFF, gi * 8 + xcd, (const bf16*)(ws + WS_GQ), (const bf16*)(ws + WS_GK), (const bf16*)(ws + WS_GV), (const float*)(ws + WS_GB), (const bf16*)(ws + WS_GR), (bf16*)(ws + WS_O));
        mb::moba_phase((char*)lds + RING_OFF, (const bf16*)(ws + WS_MQ), (const bf16*)(ws + WS_MK), (const bf16*)(ws + WS_MV), (bf16*)(ws + WS_O), (const float*)(ws + WS_KSUM), xcd, isg ? gi : 16 + 3 * gi, isg ? 1 : 3);
        if (BOTH(2)) GRID_BAR();
    }
    if (IN(3)) {
        pg8::Gemm g{(const bf16*)(ws + WS_O), (const bf16*)(ws + WS_WOUT), T, DM, DM}; pg8::StaticOrder S; S.init(T, DM, G, (int)blockIdx.x);
        pg8::EpiRes<true> E{P.x, P.out, (bf16*)(ws + WS_XB), (float*)(ws + WS_SS2)};
        pg8::gemm_phase<pg8::EpiRes<true>, pg8::StaticOrder, true, true>(l3 + RING_OFF, g, S, E);
        if (BOTH(3)) GRID_BAR();
    }
    if (IN(4)) {
        pg8::Gemm g{(const bf16*)(ws + WS_XB), (const bf16*)(ws + WS_WGU), T, 2 * DFF, DM}; pg8::StaticOrder S; S.init(T, 2 * DFF, G, (int)blockIdx.x);
        pg8::EpiUp E{(const float*)(ws + WS_SS2), (bf16*)(ws + WS_HMID)};
        pg8::gemm_phase<pg8::EpiUp, pg8::StaticOrder, true, true>(l3 + RING_OFF, g, S, E);
        if (BOTH(4)) GRID_BAR();
    }
    if (IN(5)) {
        pg8::Gemm g{(const bf16*)(ws + WS_HMID), (const bf16*)(ws + WS_WDN), T, DM, DFF}; pg8::StaticOrder S; S.init(T, DM, G, (int)blockIdx.x);
        pg8::EpiRes<false> E{P.out, P.out, nullptr, (float*)(ws + WS_SS3)};
        pg8::gemm_phase<pg8::EpiRes<false>, pg8::StaticOrder, true, true>(l3 + RING_OFF, g, S, E);
        if (BOTH(5)) GRID_BAR();
    }
    if (IN(6)) { p6_final(P, gw, NGW, lane); }
#undef IN
#undef BOTH
#undef GRID_BAR
}

__global__ __launch_bounds__(512) void naive_gla(Ptrs P) {
    __shared__ float qs[64], ks[64], as[64], vs[128], part[4][128], o2[128];
    const int bh = blockIdx.x, tid = threadIdx.x, v = tid & 127, g = tid >> 7;
    const bf16* GQ = (const bf16*)(P.ws + WS_GQ) + (size_t)bh * SEQ * 64; const bf16* GK = (const bf16*)(P.ws + WS_GK) + (size_t)bh * SEQ * 64;
    const bf16* GV = (const bf16*)(P.ws + WS_GV) + (size_t)bh * SEQ * 128; const float* GB = (const float*)(P.ws + WS_GB) + (size_t)bh * SEQ * 64;
    const bf16* GR = (const bf16*)(P.ws + WS_GR); bf16* O = (bf16*)(P.ws + WS_O); const int b = bh >> 2, h = bh & 3;
    float S[16];
    for (int i = 0; i < 16; ++i) S[i] = 0.f;
    for (int s = 0; s < SEQ; ++s) {
        if (tid < 64) { qs[tid] = bf2f(GQ[(size_t)s * 64 + tid]) * 0.125f; ks[tid] = bf2f(GK[(size_t)s * 64 + tid]);
            const float bc = GB[(size_t)s * 64 + tid], bp = (s & 63) ? GB[(size_t)(s - 1) * 64 + tid] : 0.f; as[tid] = __expf(bc - bp); }
        else if (tid < 192) vs[tid - 64] = bf2f(GV[(size_t)s * 128 + tid - 64]);
        __syncthreads();
        float acc = 0.f; const float vv = vs[v];
#pragma unroll
        for (int i = 0; i < 16; ++i) { const int d = g * 16 + i; S[i] = as[d] * S[i] + ks[d] * vv; acc += qs[d] * S[i]; }
        part[g][v] = acc;
        __syncthreads();
        float o = 0.f;
        if (tid < 128) { o = part[0][tid] + part[1][tid] + part[2][tid] + part[3][tid]; o2[tid] = o * o; }
        __syncthreads();
        if (tid < 128) { float ss = 0.f; for (int i = 0; i < 128; ++i) ss += o2[i];
            const size_t t = (size_t)b * SEQ + s; const float rs = rsqrtf(ss * (1.f / 128.f) + EPS);
            O[t * DM + h * 128 + tid] = (bf16)f2bf(o * rs * bf2f(GR[t * 512 + h * 128 + tid])); }
    }
}
__global__ __launch_bounds__(256) void naive_moba(Ptrs P) {
    __shared__ float qsh[4][128]; __shared__ float sc[4][1024];
    const int wave = threadIdx.x >> 6, lane = threadIdx.x & 63; const size_t qi = (size_t)blockIdx.x * 4 + wave;
    const int s = (int)(qi & 2047), bh = (int)(qi >> 11), b = bh >> 2, h = bh & 3, qblk = s >> 8;
    const bf16* MQ = (const bf16*)(P.ws + WS_MQ); const bf16* MK = (const bf16*)(P.ws + WS_MK) + (size_t)bh * SEQ * 128; const bf16* MV = (const bf16*)(P.ws + WS_MV) + (size_t)bh * SEQ * 128;
    const float* KS = (const float*)(P.ws + WS_KSUM);
    float* q = qsh[wave]; float* scw = sc[wave];
    q[lane] = bf2f(MQ[qi * 128 + lane]); q[lane + 64] = bf2f(MQ[qi * 128 + lane + 64]);
    __builtin_amdgcn_s_waitcnt(0xc07f); asm volatile("" ::: "memory");
    float g = -__builtin_inff();
    if (lane < 8 && lane < qblk) { const int pm = b * 8 + lane; float a = 0.f;
        for (int d = 0; d < 128; ++d) a += q[d] * (KS[((size_t)pm * 2) * 512 + h * 128 + d] + KS[((size_t)pm * 2 + 1) * 512 + h * 128 + d]) * (1.f / 256.f);
        g = a; }
    float gv[8];
#pragma unroll
    for (int j = 0; j < 8; ++j) gv[j] = __shfl(g, j);
    unsigned sel = 0;
#pragma unroll
    for (int j = 0; j < 8; ++j) { int rank = 0;
#pragma unroll
        for (int k = 0; k < 8; ++k) if (k < qblk && (gv[k] > gv[j] || (gv[k] == gv[j] && k < j))) ++rank;
        if (j < qblk && rank < 3) sel |= 1u << j; }
    const int nsl = __builtin_popcount(sel) + 1;
    const float scale = 0.08838834764831845f;
    float mx = -__builtin_inff();
    for (int blk = 0; blk <= qblk; ++blk) { const bool own = blk == qblk; if (!own && !((sel >> blk) & 1u)) continue;
        const int sl = own ? nsl - 1 : __builtin_popcount(sel & ((1u << blk) - 1u));
        for (int kk = lane; kk < 256; kk += 64) { const int key = blk * 256 + kk; float a = -__builtin_inff();
        if (key <= s) { a = 0.f; const bf16* kr = MK + (size_t)key * 128; for (int d = 0; d < 128; d += 8) { const v4u w = *(const v4u*)(kr + d);
                a += q[d] * bf2f((unsigned short)w.x) + q[d + 1] * bf2f((unsigned short)(w.x >> 16)) + q[d + 2] * bf2f((unsigned short)w.y) + q[d + 3] * bf2f((unsigned short)(w.y >> 16))
                   + q[d + 4] * bf2f((unsigned short)w.z) + q[d + 5] * bf2f((unsigned short)(w.z >> 16)) + q[d + 6] * bf2f((unsigned short)w.w) + q[d + 7] * bf2f((unsigned short)(w.w >> 16)); }
            a *= scale; }
        scw[sl * 256 + kk] = a; mx = fmaxf(mx, a); } }
    for (int o = 1; o < 64; o <<= 1) mx = fmaxf(mx, __shfl_xor(mx, o));
    float sum = 0.f;
    for (int i = lane; i < nsl * 256; i += 64) { const float p = __expf(scw[i] - mx); scw[i] = p; sum += p; }
    sum = wave_sum(sum);
    __builtin_amdgcn_s_waitcnt(0xc07f); asm volatile("" ::: "memory");
    float o0 = 0.f, o1 = 0.f;
    for (int blk = 0; blk <= qblk; ++blk) { const bool own = blk == qblk; if (!own && !((sel >> blk) & 1u)) continue;
        const int sl = own ? nsl - 1 : __builtin_popcount(sel & ((1u << blk) - 1u));
        const int kmax = own ? (s - qblk * 256 + 1) : 256;
        for (int kk = 0; kk < kmax; ++kk) { const float p = scw[sl * 256 + kk]; const bf16* vr = MV + (size_t)(blk * 256 + kk) * 128; o0 += p * bf2f(vr[lane]); o1 += p * bf2f(vr[lane + 64]); } }
    const float inv = 1.f / sum; o0 *= inv; o1 *= inv;
    const float ss = wave_sum(o0 * o0 + o1 * o1), rs = rsqrtf(ss * (1.f / 128.f) + EPS);
    bf16* O = (bf16*)(P.ws + WS_O); const size_t t = (size_t)b * SEQ + s;
    O[t * DM + 512 + h * 128 + lane] = (bf16)f2bf(o0 * rs); O[t * DM + 512 + h * 128 + lane + 64] = (bf16)f2bf(o1 * rs);
}

extern "C" void kernel_launch(void* const* d_in, const int* in_sizes, int n_in, void* d_out, int out_size, void* d_ws, size_t ws_size, hipStream_t stream) {
    static int grid = 0;
    if (grid == 0) {
        if (n_in != 14 || in_sizes[0] != T * DM || out_size != T * DM || ws_size < WS_END) { fprintf(stderr, "kernel_launch: unexpected shapes (n_in %d, in0 %d, out %d, ws %zu)\n", n_in, n_in > 0 ? in_sizes[0] : -1, out_size, ws_size); grid = -1; return; }
        int dev = 0, cus = 0, per_cu = 0;
        if (hipGetDevice(&dev) != hipSuccess || hipDeviceGetAttribute(&cus, hipDeviceAttributeMultiprocessorCount, dev) != hipSuccess) { grid = -1; return; }
        if (hipFuncSetAttribute((const void*)mega_fwd, hipFuncAttributeMaxDynamicSharedMemorySize, LDS_BYTES) != hipSuccess) { fprintf(stderr, "kernel_launch: hipFuncSetAttribute failed\n"); grid = -1; return; }
        if (hipOccupancyMaxActiveBlocksPerMultiprocessor(&per_cu, (const void*)mega_fwd, NWAVES * 64, LDS_BYTES) != hipSuccess || per_cu < 1) fprintf(stderr, "kernel_launch: occupancy query reports %d\n", per_cu);
        (void)hipGetLastError();
        grid = cus;
        if (grid != 256) { fprintf(stderr, "kernel_launch: built for a 256-CU device (got %d)\n", cus); grid = -1; return; }
    }
    if (grid < 0) return;
    Ptrs P{};
    P.x = (const float*)d_in[0]; P.pos = (const int*)d_in[1]; P.g1 = (const float*)d_in[2]; P.w_in = (const float*)d_in[3]; P.w_gup = (const float*)d_in[4]; P.b_gate = (const float*)d_in[5];
    P.gla_gain = (const float*)d_in[6]; P.moba_gain = (const float*)d_in[7]; P.w_out = (const float*)d_in[8]; P.g2 = (const float*)d_in[9]; P.w_fg = (const float*)d_in[10]; P.w_fu = (const float*)d_in[11];
    P.w_fd = (const float*)d_in[12]; P.gf = (const float*)d_in[13]; P.out = (float*)d_out; P.ws = (unsigned char*)d_ws;
    (void)hipMemsetAsync(P.ws + WS_CTL, 0, CTL_ZERO_BYTES, stream);
    Args a{}; a.P = P;
    a.ph_lo = 0; a.ph_hi = N_PHASES; a.li = 0;
    hipLaunchKernelGGL(mega_fwd, dim3(grid), dim3(NWAVES * 64), LDS_BYTES, stream, a);
}
```

```cpp
#include <hip/hip_runtime.h>
#include <cstdio>
#include <cstdint>

constexpr int BATCH = 32, SEQ = 2048, DM = 1024, T = BATCH * SEQ;
constexpr int DFF = 2816, NIN = 3088, NINP = 3328;
constexpr float EPS = 1e-6f;
constexpr int C_GQ = 0, C_GK = 256, C_GV = 512, C_GR = 1024, C_GLOW = 1536, C_MQ = 1552, C_MK = 2064, C_MV = 2576;

typedef unsigned short bf16;
typedef unsigned v4u __attribute__((ext_vector_type(4)));
typedef float f32x4 __attribute__((ext_vector_type(4)));

constexpr size_t MiB = 1u << 20;
constexpr size_t WS_CTL = 0, CTL_ZERO_BYTES = 1 * MiB;
constexpr size_t WS_WIN = 1 * MiB;
constexpr size_t WS_WOUT = 8 * MiB;
constexpr size_t WS_WGU = 10 * MiB;
constexpr size_t WS_WDN = 21 * MiB;
constexpr size_t WS_SS1 = 27 * MiB;
constexpr size_t WS_KSUM = 27 * MiB + 512 * 1024;
constexpr size_t WS_SS2 = 29 * MiB;
constexpr size_t WS_SS3 = 33 * MiB;
constexpr size_t WS_GLOW = 37 * MiB;
constexpr size_t WS_KSO = 41 * MiB;
constexpr size_t WS_ROPE = 42 * MiB;
constexpr size_t WS_XB = 74 * MiB;
constexpr size_t WS_O = 202 * MiB;
constexpr size_t WS_GQ = 330 * MiB;
constexpr size_t WS_GK = 362 * MiB;
constexpr size_t WS_GV = 394 * MiB;
constexpr size_t WS_GR = 458 * MiB;
constexpr size_t WS_GB = 522 * MiB;
constexpr size_t WS_MQ = 586 * MiB;
constexpr size_t WS_MK = 650 * MiB;
constexpr size_t WS_MV = 714 * MiB;
constexpr size_t WS_HMID = 330 * MiB;
constexpr size_t WS_END = 778 * MiB;

__device__ __forceinline__ unsigned f2bf(float f) { unsigned u = __builtin_bit_cast(unsigned, f); return (u + 0x7fffu + ((u >> 16) & 1u)) >> 16; }
__device__ __forceinline__ unsigned pk2(float lo, float hi) { return f2bf(lo) | (f2bf(hi) << 16); }
__device__ __forceinline__ float bf2f(unsigned short u) { return __builtin_bit_cast(float, (unsigned)u << 16); }
__device__ __forceinline__ float wave_sum(float v) {
#pragma unroll
    for (int o = 1; o < 64; o <<= 1) v += __shfl_xor(v, o);
    return v;
}
__device__ __forceinline__ float silu_f(float x) { return x / (1.f + __expf(-x)); }
__device__ __forceinline__ float logsigmoid_f(float x) { return fminf(x, 0.f) - log1pf(__expf(-fabsf(x))); }

struct Ptrs {
    const float* x; const int* pos; const float* g1; const float* w_in; const float* w_gup; const float* b_gate; const float* gla_gain; const float* moba_gain;
    const float* w_out; const float* g2; const float* w_fg; const float* w_fu; const float* w_fd; const float* gf;
    float* out; unsigned char* ws;
};

__host__ __device__ inline int win_src(int np) {
    const int pn = np >> 8, j = np & 255;
    switch (pn) {
    case 0: return C_GQ + j;
    case 1: return C_GK + j;
    case 2: case 3: return C_GV + (pn - 2) * 256 + j;
    case 4: case 5: return C_GR + (pn - 4) * 256 + j;
    case 6: return -1;
    case 7: case 8: case 9: case 10: {
        const int base = pn < 9 ? C_MQ : C_MK, p = pn < 9 ? pn - 7 : pn - 9;
        const int jj = j & 127, head = 2 * p + (jj >> 6), dim = (j >> 7) * 64 + (jj & 63);
        return base + head * 128 + dim; }
    default: return C_MV + (pn - 11) * 256 + j;
    }
}
__device__ __forceinline__ void p0_tr_item(const float* W, int ldw, int srcn0, const float* ks, int ksmod, bf16* WT, int ldwt, int destn0, int k0, float* scr, int lane) {
#pragma unroll 8
    for (int i = 0; i < 32; ++i) { const int kk = 2 * i + (lane >> 5), k = k0 + kk; float sc = 1.f; if (ks) sc = ks[ksmod ? (k % ksmod) : k];
        scr[kk * 33 + (lane & 31)] = W[(size_t)k * ldw + srcn0 + (lane & 31)] * sc; }
    __builtin_amdgcn_s_waitcnt(0xc07f); asm volatile("" ::: "memory");
    const int c = lane & 7;
#pragma unroll
    for (int j = 0; j < 4; ++j) { const int n = (lane >> 3) + 8 * j; const float* s = scr + (8 * c) * 33 + n;
        v4u o; o.x = pk2(s[0 * 33], s[1 * 33]); o.y = pk2(s[2 * 33], s[3 * 33]); o.z = pk2(s[4 * 33], s[5 * 33]); o.w = pk2(s[6 * 33], s[7 * 33]);
        *(v4u*)(WT + (size_t)(destn0 + n) * ldwt + k0 + 8 * c) = o; }
    __builtin_amdgcn_s_waitcnt(0xc07f); asm volatile("" ::: "memory");
}
__device__ __forceinline__ void p0_gate_item(const Ptrs& P, bf16* WT, int n0  , int k0, float* scr, int lane) {
    const int n = lane & 31;
    float wu[16];
#pragma unroll
    for (int r = 0; r < 16; ++r) wu[r] = P.w_gup[r * 256 + n0 + n];
    for (int i = 0; i < 32; ++i) { const int kk = 2 * i + (lane >> 5), k = k0 + kk; const float* wr = P.w_in + (size_t)k * NIN + C_GLOW; float a = 0.f;
#pragma unroll
        for (int r = 0; r < 16; ++r) a += wr[r] * wu[r];
        scr[kk * 33 + n] = a * P.g1[k]; }
    __builtin_amdgcn_s_waitcnt(0xc07f); asm volatile("" ::: "memory");
    const int c = lane & 7;
#pragma unroll
    for (int j = 0; j < 4; ++j) { const int nn = (lane >> 3) + 8 * j; const float* s = scr + (8 * c) * 33 + nn;
        v4u o; o.x = pk2(s[0 * 33], s[1 * 33]); o.y = pk2(s[2 * 33], s[3 * 33]); o.z = pk2(s[4 * 33], s[5 * 33]); o.w = pk2(s[6 * 33], s[7 * 33]);
        *(v4u*)(WT + (size_t)(6 * 256 + n0 + nn) * DM + k0 + 8 * c) = o; }
    __builtin_amdgcn_s_waitcnt(0xc07f); asm volatile("" ::: "memory");
}
__device__ __forceinline__ void p0_prologue(const Ptrs& P, float* scr_all, int gw, int NGW, int lane, int wave) {
    float* scr = scr_all + wave * (64 * 33);
    unsigned char* ws = P.ws;
    bf16* WIN = (bf16*)(ws + WS_WIN); bf16* WOUT = (bf16*)(ws + WS_WOUT); bf16* WGU = (bf16*)(ws + WS_WGU); bf16* WDN = (bf16*)(ws + WS_WDN);
    constexpr int I_IN = (NINP / 32) * (DM / 64), I_OUT = (DM / 32) * (DM / 64), I_GU = (2 * DFF / 32) * (DM / 64), I_DN = (DM / 32) * (DFF / 64);
    constexpr int NITEMS = I_IN + I_OUT + I_GU + I_DN;
    for (int it = gw; it < NITEMS; it += NGW) {
        int r = it;
        if (r < I_IN) { const int nb = r / (DM / 64), kb = r % (DM / 64), np0 = nb * 32, src = win_src(np0);
            if (src < 0) p0_gate_item(P, WIN, np0 & 255, kb * 64, scr, lane);
            else p0_tr_item(P.w_in, NIN, src, P.g1, 0, WIN, DM, np0, kb * 64, scr, lane);
            continue; }
        r -= I_IN;
        if (r < I_OUT) { const int nb = r / (DM / 64), kb = r % (DM / 64), k0 = kb * 64;
            p0_tr_item(P.w_out, DM, nb * 32, k0 < 512 ? P.gla_gain : P.moba_gain, 128, WOUT, DM, nb * 32, k0, scr, lane); continue; }
        r -= I_OUT;
        if (r < I_GU) { const int nb = r / (DM / 64), kb = r % (DM / 64), np0 = nb * 32, pn = np0 >> 8, j = np0 & 255;
            const float* W = j < 128 ? P.w_fg : P.w_fu; const int src = pn * 128 + (j & 127);
            p0_tr_item(W, DFF, src, P.g2, 0, WGU, DM, np0, kb * 64, scr, lane); continue; }
        r -= I_GU;
        { const int nb = r / (DFF / 64), kb = r % (DFF / 64);
            p0_tr_item(P.w_fd, DM, nb * 32, nullptr, 0, WDN, DFF, nb * 32, kb * 64, scr, lane); }
    }
    bf16* XB = (bf16*)(ws + WS_XB); float* SS1 = (float*)(ws + WS_SS1);
    for (int m = gw; m < T; m += NGW) {
        const f32x4* xr = (const f32x4*)(P.x + (size_t)m * DM) + lane; f32x4 v[4]; float s = 0.f;
#pragma unroll
        for (int j = 0; j < 4; ++j) { v[j] = xr[64 * j]; s += (v[j].x * v[j].x + v[j].y * v[j].y) + (v[j].z * v[j].z + v[j].w * v[j].w); }
        s = wave_sum(s);
        unsigned long long* o8 = (unsigned long long*)(XB + (size_t)m * DM) + lane;
#pragma unroll
        for (int j = 0; j < 4; ++j) o8[64 * j] = (unsigned long long)pk2(v[j].x, v[j].y) | ((unsigned long long)pk2(v[j].z, v[j].w) << 32);
        if (lane == 0) SS1[m] = s;
    }
    float* KSO = (float*)(ws + WS_KSO);
    if (gw == 0) for (int k = lane; k < DM; k += 64) KSO[k] = k < 512 ? P.gla_gain[k & 127] : P.moba_gain[k & 127];
}

namespace pg8 {
#define PG8_LAS __attribute__((address_space(3)))
typedef unsigned short bf16_t;
typedef short bf16x8 __attribute__((ext_vector_type(8)));
typedef float f32x4 __attribute__((ext_vector_type(4)));
typedef unsigned u32x4 __attribute__((ext_vector_type(4)));
constexpr int BM = 256, BK = 64, HALF = 128, HTB = HALF * BK * 2  , STAGE_BYTES = 8 * HTB, NXCD = 8, WGM = 8;

__host__ __device__ __forceinline__ int lds_byte(int r, int c) { const int st = (r >> 4) * 2 + (c >> 5), rr = r & 15, cc = c & 31, ob = rr * 64 + cc * 2; return st * 1024 + (ob ^ (((ob >> 9) & 1) << 5)); }
__host__ __device__ __forceinline__ void stage_rc(int b, int& R, int& C) { const int st = b / 1024, sb = b % 1024, swz = sb ^ (((sb >> 9) & 1) << 5); R = (st >> 1) * 16 + swz / 64; C = (st & 1) * 32 + (swz % 64) / 2; }
__host__ __device__ __forceinline__ int perm32(int rho) { const int n = rho >> 4, i = rho & 15; return 8 * (i >> 2) + 4 * n + (i & 3); }

struct Unit { int pm, pn; };
struct Gemm { const bf16_t* A; const bf16_t* Bt; int M, N, K; };

struct StaticOrder {
    int nM, nN, nwg, G, c;
    __host__ __device__ void init(int M, int N, int G_, int c_) { nM = M / BM; nN = N / BM; nwg = nM * nN; G = G_; c = c_; }
    __host__ __device__ bool next(int i, Unit& u) const {
        const long L = (long)i * G + c; if (L >= nwg) return false;
        int wgid = (int)L; { const int q = nwg / NXCD, r = nwg % NXCD, xcd = wgid % NXCD, off = wgid / NXCD; wgid = (xcd < r ? xcd * (q + 1) : r * (q + 1) + (xcd - r) * q) + off; }
        const int nig = WGM * nN, gid = wgid / nig, fm = gid * WGM, gsz = (nM - fm) < WGM ? (nM - fm) : WGM;
        u.pm = fm + ((wgid % nig) % gsz); u.pn = (wgid % nig) / gsz; return true;
    }
    __device__ __forceinline__ void a_ready(const Unit&) const {}
    __device__ __forceinline__ void done(const Unit&) const {}
};

__device__ __forceinline__ unsigned cvt_pk_bf16(float lo, float hi) { unsigned r; asm volatile("v_cvt_pk_bf16_f32 %0, %1, %2" : "=v"(r) : "v"(lo), "v"(hi)); return r; }
__device__ __forceinline__ u32x4 pack8(f32x4 a, f32x4 b) { u32x4 w; w.x = cvt_pk_bf16(a[0], a[1]); w.y = cvt_pk_bf16(a[2], a[3]); w.z = cvt_pk_bf16(b[0], b[1]); w.w = cvt_pk_bf16(b[2], b[3]); return w; }
__device__ __forceinline__ float fast_silu(float v) { return v * __builtin_amdgcn_rcpf(1.f + __builtin_amdgcn_exp2f(-1.4426950408889634f * v)); }
__device__ __forceinline__ float fast_logsigmoid(float x) { return fminf(x, 0.f) - 0.6931471805599453f * __builtin_amdgcn_logf(1.f + __builtin_amdgcn_exp2f(-1.4426950408889634f * fabsf(x))); }
template <int CTRL> __device__ __forceinline__ float dpp_shr0(float x) { return __builtin_bit_cast(float, __builtin_amdgcn_update_dpp(0, __builtin_bit_cast(int, x), CTRL, 0xf, 0xf, false)); }
__device__ __forceinline__ float row_scan16(float x) { x += dpp_shr0<0x111>(x); x += dpp_shr0<0x112>(x); x += dpp_shr0<0x114>(x); x += dpp_shr0<0x118>(x); return x; }

struct EpiIn {
    static constexpr bool PERM = true, AFTER_DRAIN = false;
    unsigned char* ws; const float* b_gate; const int* pos;
    __device__ __forceinline__ void operator()(const f32x4 (&acc)[2][2][4][2], const Unit& u, int wr, int wc, int fr, int fq) const {
        asm volatile("" : "+v"(fr), "+v"(fq));
        const int pn = u.pn, pm = u.pm, b = pm >> 3, s0 = (pm & 7) * 256 + wr * 64 + fr, t0 = pm * 256 + wr * 64 + fr, lc = wc * 32 + fq * 8;
        float r1[2][4];
#pragma unroll
        for (int ai = 0; ai < 2; ++ai)
#pragma unroll
            for (int m = 0; m < 4; ++m) r1[ai][m] = rsqrtf(((const float*)(ws + WS_SS1))[t0 + ai * 128 + m * 16] * (1.f / DM) + EPS);
        if (pn <= 1) {
            bf16* dst = (bf16*)(ws + (pn == 0 ? WS_GQ : WS_GK));
#pragma unroll
            for (int bj = 0; bj < 2; ++bj) { const int h = 2 * bj + (wc >> 1), d = (wc & 1) * 32 + fq * 8;
#pragma unroll
                for (int ai = 0; ai < 2; ++ai)
#pragma unroll
                    for (int m = 0; m < 4; ++m) { const float r = r1[ai][m];
                        *(u32x4*)(dst + (((size_t)b * 4 + h) * SEQ + s0 + ai * 128 + m * 16) * 64 + d) = pack8(acc[ai][bj][m][0] * r, acc[ai][bj][m][1] * r); } }
        } else if (pn == 2 || pn == 3 || pn >= 11) {
            bf16* dst = (bf16*)(ws + (pn >= 11 ? WS_MV : WS_GV)); const int hb = 2 * (pn >= 11 ? pn - 11 : pn - 2);
#pragma unroll
            for (int bj = 0; bj < 2; ++bj)
#pragma unroll
                for (int ai = 0; ai < 2; ++ai)
#pragma unroll
                    for (int m = 0; m < 4; ++m) { const float r = r1[ai][m];
                        *(u32x4*)(dst + (((size_t)b * 4 + hb + bj) * SEQ + s0 + ai * 128 + m * 16) * 128 + lc) = pack8(acc[ai][bj][m][0] * r, acc[ai][bj][m][1] * r); }
        } else if (pn == 4 || pn == 5) {
            bf16* dst = (bf16*)(ws + WS_GR) + (pn - 4) * 256 + lc;
#pragma unroll
            for (int bj = 0; bj < 2; ++bj)
#pragma unroll
                for (int ai = 0; ai < 2; ++ai)
#pragma unroll
                    for (int m = 0; m < 4; ++m) { const float r = r1[ai][m]; f32x4 v0 = acc[ai][bj][m][0] * r, v1 = acc[ai][bj][m][1] * r;
#pragma unroll
                        for (int i = 0; i < 4; ++i) { v0[i] = fast_silu(v0[i]); v1[i] = fast_silu(v1[i]); }
                        *(u32x4*)(dst + (size_t)(t0 + ai * 128 + m * 16) * 512 + bj * 128) = pack8(v0, v1); }
        } else if (pn == 6) {
            float* dst = (float*)(ws + WS_GB);
#pragma unroll
            for (int bj = 0; bj < 2; ++bj) { const int h = 2 * bj + (wc >> 1), d = (wc & 1) * 32 + fq * 8;
#pragma unroll
                for (int n = 0; n < 2; ++n) { const f32x4 bg = *(const f32x4*)(b_gate + bj * 128 + lc + 4 * n);
#pragma unroll
                    for (int ai = 0; ai < 2; ++ai) { f32x4 run = {0.f, 0.f, 0.f, 0.f};
#pragma unroll
                        for (int m = 0; m < 4; ++m) { f32x4 v = acc[ai][bj][m][n] * r1[ai][m] + bg, tot;
#pragma unroll
                            for (int i = 0; i < 4; ++i) { v[i] = row_scan16(fast_logsigmoid(v[i]) * (1.f / 16.f)); tot[i] = __shfl(v[i], 15, 16); }
                            v = v + run; run = run + tot;
                            *(f32x4*)(dst + (((size_t)b * 4 + h) * SEQ + s0 + ai * 128 + m * 16) * 64 + d + 4 * n) = v; } } } }
        } else {
            const bool isk = pn >= 9; const int p = isk ? pn - 9 : pn - 7, h = 2 * p + (wc >> 1), i0 = (wc & 1) * 32 + fq * 8;
            bf16* dst = (bf16*)(ws + (isk ? WS_MK : WS_MQ));
            float posf[2][4];
#pragma unroll
            for (int ai = 0; ai < 2; ++ai)
#pragma unroll
                for (int m = 0; m < 4; ++m) posf[ai][m] = (float)pos[t0 + ai * 128 + m * 16];
            typedef unsigned u32x2 __attribute__((ext_vector_type(2)));
#pragma unroll
            for (int n = 0; n < 2; ++n) { f32x4 ks1 = {0.f, 0.f, 0.f, 0.f}, ks2 = ks1;
                f32x4 invf;
#pragma unroll
                for (int e = 0; e < 4; ++e) invf[e] = __builtin_amdgcn_exp2f(-(float)(i0 + 4 * n + e) * 0.20762050593046014f);
                unsigned dof = (unsigned)(((((b * 4 + h) * SEQ + s0) * 128) + i0 + 4 * n) * 2);
                char* dstb = (char*)dst;
#pragma unroll
                for (int ai = 0; ai < 2; ++ai) {
#pragma unroll
                    for (int m = 0; m < 4; ++m) { const float r = r1[ai][m];
                        const f32x4 x = acc[ai][0][m][n] * r, y = acc[ai][1][m][n] * r; f32x4 o1, o2;
#pragma unroll
                        for (int e = 0; e < 4; ++e) { const float rev = __builtin_amdgcn_fractf((posf[ai][m] * invf[e]) * 0.15915494309189535f);
                            const float cs = __builtin_amdgcn_cosf(rev), sn = __builtin_amdgcn_sinf(rev);
                            o1[e] = x[e] * cs - y[e] * sn; o2[e] = y[e] * cs + x[e] * sn; }
                        u32x2 w1, w2; w1.x = cvt_pk_bf16(o1[0], o1[1]); w1.y = cvt_pk_bf16(o1[2], o1[3]); w2.x = cvt_pk_bf16(o2[0], o2[1]); w2.y = cvt_pk_bf16(o2[2], o2[3]);
                        *(u32x2*)(dstb + dof) = w1; *(u32x2*)(dstb + dof + 128) = w2;
                        ks1 = ks1 + o1; ks2 = ks2 + o2;
                        dof += 16 * 256; asm volatile("" : "+v"(dof)); }
                    dof += 64 * 256; asm volatile("" : "+v"(dof)); }
                if (isk) {
#pragma unroll
                    for (int o = 1; o < 16; o <<= 1)
#pragma unroll
                        for (int i = 0; i < 4; ++i) { ks1[i] += __shfl_xor(ks1[i], o); ks2[i] += __shfl_xor(ks2[i], o); }
                    if (fr == 0) { float* kp = (float*)(ws + WS_KSUM) + ((size_t)pm * 2 + wr) * 512 + h * 128 + i0 + 4 * n; *(f32x4*)kp = ks1; *(f32x4*)(kp + 64) = ks2; } } }
        }
    }
};
template <int MODE> struct EpiRes {
    static constexpr bool PERM = true, AFTER_DRAIN = false;
    const float* base; float* out; bf16* xb; float* ss;
    __device__ __forceinline__ void operator()(const f32x4 (&acc)[2][2][4][2], const Unit& u, int wr, int wc, int fr, int fq) const {
        asm volatile("" : "+v"(fr), "+v"(fq));
        const int row0 = u.pm * BM + wr * 64 + fr, col0 = u.pn * BM + wc * 32 + fq * 8;
#pragma unroll
        for (int ai = 0; ai < 2; ++ai)
#pragma unroll
            for (int m = 0; m < 4; ++m) { const size_t row = row0 + ai * 128 + m * 16; float sp = 0.f;
#pragma unroll
                for (int bj = 0; bj < 2; ++bj) { const size_t off = row * DM + col0 + bj * 128; f32x4 v0, v1;
                    if (MODE == 0) { v0 = *(const f32x4*)(base + off) + acc[ai][bj][m][0]; v1 = *(const f32x4*)(base + off + 4) + acc[ai][bj][m][1]; *(u32x4*)(xb + off) = pack8(v0, v1); }
                    else { const u32x4 w = *(const u32x4*)(xb + off);
                        v0 = (f32x4){__uint_as_float(w.x << 16), __uint_as_float(w.x & 0xffff0000u), __uint_as_float(w.y << 16), __uint_as_float(w.y & 0xffff0000u)} + acc[ai][bj][m][0];
                        v1 = (f32x4){__uint_as_float(w.z << 16), __uint_as_float(w.z & 0xffff0000u), __uint_as_float(w.w << 16), __uint_as_float(w.w & 0xffff0000u)} + acc[ai][bj][m][1];
                        *(f32x4*)(out + off) = v0; *(f32x4*)(out + off + 4) = v1; }
                    sp += (v0[0] * v0[0] + v0[1] * v0[1]) + (v0[2] * v0[2] + v0[3] * v0[3]) + (v1[0] * v1[0] + v1[1] * v1[1]) + (v1[2] * v1[2] + v1[3] * v1[3]); }
                sp += __shfl_xor(sp, 16); sp += __shfl_xor(sp, 32);
                if (fq == 0) ss[row * 16 + u.pn * 4 + wc] = sp; }
    }
};
struct EpiUp {
    static constexpr bool PERM = true, AFTER_DRAIN = false;
    const float* ss; bf16* hm;
    __device__ __forceinline__ void operator()(const f32x4 (&acc)[2][2][4][2], const Unit& u, int wr, int wc, int fr, int fq) const {
        asm volatile("" : "+v"(fr), "+v"(fq));
        const int row0 = u.pm * BM + wr * 64 + fr, col0 = u.pn * 128 + wc * 32 + fq * 8;
#pragma unroll
        for (int ai = 0; ai < 2; ++ai)
#pragma unroll
            for (int m = 0; m < 4; ++m) { const size_t row = row0 + ai * 128 + m * 16; const f32x4* sp = (const f32x4*)(ss + row * 16);
                const f32x4 s4 = (sp[0] + sp[1]) + (sp[2] + sp[3]); const float r2 = rsqrtf(((s4[0] + s4[1]) + (s4[2] + s4[3])) * (1.f / DM) + EPS);
                f32x4 g0 = acc[ai][0][m][0] * r2, g1 = acc[ai][0][m][1] * r2; const f32x4 u0 = acc[ai][1][m][0] * r2, u1 = acc[ai][1][m][1] * r2;
#pragma unroll
                for (int i = 0; i < 4; ++i) { g0[i] = fast_silu(g0[i]) * u0[i]; g1[i] = fast_silu(g1[i]) * u1[i]; }
                *(u32x4*)(hm + row * DFF + col0) = pack8(g0, g1); }
    }
};

template <class Epi, class Sched, bool ALIGN_EPI = false, bool SP2 = false>
__device__ __forceinline__ void gemm_phase(PG8_LAS unsigned char* lds, const Gemm g, const Sched& S, const Epi& E) {
    const int tid = threadIdx.x, wid = __builtin_amdgcn_readfirstlane(tid >> 6), lane = tid & 63, wr = wid >> 2, wc = wid & 3, fr = lane & 15, fq = lane >> 4;
    const int K = g.K, nt = K / BK;
    unsigned voffA[2], voffB[2];
#pragma unroll
    for (int i = 0; i < 2; ++i) { int R, C; stage_rc(tid * 16 + i * 8192, R, C); const int Rb = Epi::PERM ? ((R & ~31) + perm32(R & 31)) : R;
        voffA[i] = (unsigned)(R * K + C) * 2u; voffB[i] = (unsigned)(Rb * K + C) * 2u; }
    const size_t kstep = (size_t)(BK * 2);
    const size_t hstep = (size_t)HALF * K * 2;
    const size_t tstep = 2 * hstep;
    const unsigned ldsw = (unsigned)wid * 1024u;
    const int aoff = lds_byte(wr * 64 + fr, fq * 8), boff = lds_byte(wc * 32 + fr, fq * 8);
#define PG8_SA(b, h) (((b) * 2 + (h)) * HTB)
#define PG8_SB(b, h) ((4 + (b) * 2 + (h)) * HTB)
#define PG8_STAGE(bufoff, gbase, voff) do { _Pragma("unroll") for (int _i = 0; _i < 2; ++_i) \
        __builtin_amdgcn_global_load_lds((const unsigned*)((const char*)(gbase) + (voff)[_i]), (PG8_LAS unsigned*)(lds + (bufoff) + ldsw + _i * 8192), 16, 0, 0); } while (0)
#define PG8_LDA(dst, b, h) do { _Pragma("unroll") for (int m = 0; m < 4; ++m) _Pragma("unroll") for (int k = 0; k < 2; ++k) dst[m][k] = *(const PG8_LAS bf16x8*)(lds + PG8_SA(b, h) + aoff + m * 2048 + k * 1024); } while (0)
#define PG8_LDB(dst, b, h) do { _Pragma("unroll") for (int n = 0; n < 2; ++n) _Pragma("unroll") for (int k = 0; k < 2; ++k) dst[n][k] = *(const PG8_LAS bf16x8*)(lds + PG8_SB(b, h) + boff + n * 2048 + k * 1024); } while (0)
#define PG8_MMA(ai, bj, At, Bt) do { __builtin_amdgcn_s_setprio(1); _Pragma("unroll") for (int m = 0; m < 4; ++m) _Pragma("unroll") for (int n = 0; n < 2; ++n) _Pragma("unroll") for (int k = 0; k < 2; ++k) \
        acc[ai][bj][m][n] = __builtin_amdgcn_mfma_f32_16x16x32_bf16(Bt[n][k], At[m][k], acc[ai][bj][m][n], 0, 0, 0); __builtin_amdgcn_s_setprio(0); } while (0)
#define PG8_WAIT_V(n) asm volatile("s_waitcnt vmcnt(" #n ")" ::: "memory")
#define PG8_WAIT_L(n) asm volatile("s_waitcnt lgkmcnt(" #n ")" ::: "memory")
#define PG8_BAR __builtin_amdgcn_s_barrier()
#define PG8_SCHED __builtin_amdgcn_sched_barrier(0)
    Unit cur, nxt; int ui = 0;
    if (!S.next(0, cur)) return;
    f32x4 acc[2][2][4][2];
#pragma unroll
    for (int a = 0; a < 2; ++a)
#pragma unroll
        for (int b = 0; b < 2; ++b)
#pragma unroll
            for (int m = 0; m < 4; ++m)
#pragma unroll
                for (int n = 0; n < 2; ++n) acc[a][b][m][n] = (f32x4){0.f, 0.f, 0.f, 0.f};
    bf16x8 At[4][2], B0[2][2], B1[2][2];
    const char* cA = (const char*)g.A + (size_t)cur.pm * tstep; const char* cB = (const char*)g.Bt + (size_t)cur.pn * tstep;
    S.a_ready(cur);
    if constexpr (SP2) {
        PG8_STAGE(PG8_SB(0, 0), cB, voffB); PG8_STAGE(PG8_SB(0, 1), cB + hstep, voffB); PG8_STAGE(PG8_SA(0, 0), cA, voffA); PG8_STAGE(PG8_SA(0, 1), cA + hstep, voffA);
        if (wr == 1) PG8_BAR;
        PG8_WAIT_V(2); PG8_BAR;
        PG8_STAGE(PG8_SB(1, 0), cB + kstep, voffB); PG8_STAGE(PG8_SA(1, 0), cA + kstep, voffA); PG8_STAGE(PG8_SB(1, 1), cB + hstep + kstep, voffB);
        PG8_WAIT_V(6); PG8_BAR;
    } else {
        PG8_STAGE(PG8_SB(0, 0), cB, voffB); PG8_STAGE(PG8_SA(0, 0), cA, voffA); PG8_STAGE(PG8_SB(0, 1), cB + hstep, voffB); PG8_STAGE(PG8_SA(0, 1), cA + hstep, voffA);
        if (wr == 1) PG8_BAR;
        PG8_WAIT_V(4); PG8_BAR;
        PG8_STAGE(PG8_SB(1, 0), cB + kstep, voffB); PG8_STAGE(PG8_SA(1, 0), cA + kstep, voffA); PG8_STAGE(PG8_SB(1, 1), cB + hstep + kstep, voffB);
        PG8_WAIT_V(6); PG8_BAR;
    }
    for (;;) {
        const bool has_next = S.next(ui + 1, nxt);
        const char* nA = has_next ? (const char*)g.A + (size_t)nxt.pm * tstep : cA; const char* nB = has_next ? (const char*)g.Bt + (size_t)nxt.pn * tstep : cB;
        for (int t = 0; t < nt; t += 2) {
            const bool last = (t == nt - 2);
            const char* a1 = cA + (size_t)(t + 1) * kstep;
            const char* a2 = last ? nA : cA + (size_t)(t + 2) * kstep; const char* b2 = last ? nB : cB + (size_t)(t + 2) * kstep;
            const char* a3 = a2 + kstep; const char* b3 = b2 + kstep;
            if (last && has_next) S.a_ready(nxt);
            if constexpr (SP2) {
            PG8_LDB(B0, 0, 0); PG8_LDB(B1, 0, 1); PG8_SCHED; PG8_LDA(At, 0, 0); PG8_STAGE(PG8_SA(1, 1), a1 + hstep, voffA);
            PG8_WAIT_V(8); PG8_WAIT_L(0); PG8_BAR; PG8_MMA(0, 0, At, B0); PG8_MMA(0, 1, At, B1); PG8_BAR; PG8_SCHED;
            PG8_LDA(At, 0, 1); PG8_STAGE(PG8_SB(0, 0), b2, voffB); PG8_STAGE(PG8_SB(0, 1), b2 + hstep, voffB); PG8_STAGE(PG8_SA(0, 0), a2, voffA);
            PG8_WAIT_V(8); PG8_WAIT_L(0); PG8_BAR; PG8_MMA(1, 0, At, B0); PG8_MMA(1, 1, At, B1); PG8_BAR; PG8_SCHED;
            PG8_LDB(B0, 1, 0); PG8_LDB(B1, 1, 1); PG8_SCHED; PG8_LDA(At, 1, 0); PG8_STAGE(PG8_SA(0, 1), a2 + hstep, voffA);
            PG8_WAIT_V(8); PG8_WAIT_L(0); PG8_BAR; PG8_MMA(0, 0, At, B0); PG8_MMA(0, 1, At, B1); PG8_BAR; PG8_SCHED;
            PG8_LDA(At, 1, 1); PG8_STAGE(PG8_SB(1, 0), b3, voffB); PG8_STAGE(PG8_SB(1, 1), b3 + hstep, voffB); PG8_STAGE(PG8_SA(1, 0), a3, voffA);
            PG8_WAIT_V(8); PG8_WAIT_L(0); PG8_BAR; PG8_MMA(1, 0, At, B0); PG8_MMA(1, 1, At, B1); PG8_BAR; PG8_SCHED;
            } else {
            PG8_LDB(B0, 0, 0); PG8_SCHED; PG8_LDA(At, 0, 0); PG8_STAGE(PG8_SA(1, 1), a1 + hstep, voffA);
            PG8_WAIT_L(8); PG8_BAR; PG8_WAIT_L(0); PG8_MMA(0, 0, At, B0); PG8_BAR; PG8_SCHED;
            PG8_LDB(B1, 0, 1); PG8_STAGE(PG8_SB(0, 0), b2, voffB);
            PG8_BAR; PG8_WAIT_L(0); PG8_MMA(0, 1, At, B1); PG8_BAR;
            PG8_LDA(At, 0, 1); PG8_STAGE(PG8_SA(0, 0), a2, voffA);
            PG8_BAR; PG8_WAIT_L(0); PG8_MMA(1, 0, At, B0); PG8_BAR; PG8_SCHED;
            PG8_STAGE(PG8_SB(0, 1), b2 + hstep, voffB);
            PG8_WAIT_V(6); PG8_BAR; PG8_MMA(1, 1, At, B1); PG8_BAR;
            PG8_LDB(B0, 1, 0); PG8_SCHED; PG8_LDA(At, 1, 0); PG8_STAGE(PG8_SA(0, 1), a2 + hstep, voffA);
            PG8_WAIT_L(8); PG8_BAR; PG8_WAIT_L(0); PG8_MMA(0, 0, At, B0); PG8_BAR; PG8_SCHED;
            PG8_LDB(B1, 1, 1); PG8_STAGE(PG8_SB(1, 0), b3, voffB);
            PG8_BAR; PG8_WAIT_L(0); PG8_MMA(0, 1, At, B1); PG8_BAR;
            PG8_LDA(At, 1, 1); PG8_STAGE(PG8_SA(1, 0), a3, voffA);
            PG8_BAR; PG8_WAIT_L(0); PG8_MMA(1, 0, At, B0); PG8_BAR; PG8_SCHED;
            PG8_STAGE(PG8_SB(1, 1), b3 + hstep, voffB);
            PG8_WAIT_V(6); PG8_BAR; PG8_MMA(1, 1, At, B1); PG8_BAR;
            }
        }
        if constexpr (ALIGN_EPI) { if (wr == 0) PG8_BAR; }
        if constexpr (!Epi::AFTER_DRAIN) { E(acc, cur, wr, wc, fr, fq); S.done(cur); }
        if (!has_next) break;
#pragma unroll
        for (int a = 0; a < 2; ++a)
#pragma unroll
            for (int b = 0; b < 2; ++b)
#pragma unroll
                for (int m = 0; m < 4; ++m)
#pragma unroll
                    for (int n = 0; n < 2; ++n) acc[a][b][m][n] = (f32x4){0.f, 0.f, 0.f, 0.f};
        cur = nxt; cA = nA; cB = nB; ++ui;
        if constexpr (ALIGN_EPI) { if (wr == 1) PG8_BAR; }
    }
    PG8_WAIT_V(0);
    if constexpr (!ALIGN_EPI) { if (wr == 0) PG8_BAR; }
    PG8_BAR;
    if constexpr (Epi::AFTER_DRAIN) { E.fused(acc, cur, wr, wc, fr, fq, lds, wid, lane); S.done(cur); }
#undef PG8_SA
#undef PG8_SB
#undef PG8_STAGE
#undef PG8_LDA
#undef PG8_LDB
#undef PG8_MMA
#undef PG8_WAIT_V
#undef PG8_WAIT_L
#undef PG8_BAR
#undef PG8_SCHED
}
}

#define LAS __attribute__((address_space(3)))
#define XB_TMO      128
#define XB_XCNT(j)  (256  + 64 * (j))
#define XB_XSUB(j)  (1280 + 64 * (j))
#define XB_XGEN(j)  (2304 + 64 * (j))
#define XB_TOP      3328
#define XB_TOPGEN   3392
#define XCD_BAR_WORDS 3456
#define XB_SPIN_CAP (1u << 18)

__device__ __forceinline__ unsigned xb_ld(unsigned* p)              { return __hip_atomic_load(p, __ATOMIC_RELAXED, __HIP_MEMORY_SCOPE_AGENT); }
__device__ __forceinline__ unsigned xb_add(unsigned* p, unsigned v) { return __hip_atomic_fetch_add(p, v, __ATOMIC_RELAXED, __HIP_MEMORY_SCOPE_AGENT); }
__device__ __forceinline__ unsigned xb_xcc_id() { return (unsigned)__builtin_amdgcn_s_getreg((3 << 11) | 20) & 0xFu; }
#define XB_SPIN(cond, bar) do { unsigned _sp = 0; while (cond) { __builtin_amdgcn_s_sleep(1); \
    if ((++_sp & 255u) == 0u) { if (xb_ld(&(bar)[XB_TMO])) break; if (_sp > XB_SPIN_CAP) { atomicAdd(&(bar)[XB_TMO], 1u); break; } } } } while (0)

struct XcdBarrier {
    unsigned* bar; unsigned x;
    volatile LAS unsigned* st;
};

__device__ __forceinline__ XcdBarrier xcd_barrier_post(unsigned* bar, volatile LAS unsigned* st) {
    XcdBarrier b; b.bar = bar; b.x = xb_xcc_id(); b.st = st;
    if (threadIdx.x == 0) (void)xb_add(&bar[XB_XCNT(b.x)], 1u);
    return b;
}
__device__ __forceinline__ void xcd_barrier_complete(unsigned* bar, unsigned x, unsigned& nloc, unsigned& nx) {
    const unsigned G = gridDim.x * gridDim.y * gridDim.z;
    unsigned sum, cnt, mine, sp = 0u;
    for (;;) {
        sum = 0u; cnt = 0u; mine = 0u;
#pragma unroll
        for (unsigned j = 0; j < 16; ++j) { const unsigned c = xb_ld(&bar[XB_XCNT(j)]); sum += c; cnt += (c > 0u) ? 1u : 0u; mine = (j == x) ? c : mine; }
        if (sum == G) break;
        __builtin_amdgcn_s_sleep(1);
        if ((++sp & 255u) == 0u) { if (xb_ld(&bar[XB_TMO])) break; if (sp > XB_SPIN_CAP) { atomicAdd(&bar[XB_TMO], 1u); break; } }
    }
    nloc = mine > 0u ? mine : 1u; nx = cnt > 0u ? cnt : 1u;
}

__device__ __forceinline__ void xcd_barrier(const XcdBarrier& b) {
    asm volatile("s_waitcnt vmcnt(0)" ::: "memory");
    __syncthreads();
    if (threadIdx.x == 0) {
        unsigned* bar = b.bar;
        __builtin_amdgcn_s_waitcnt(0);
        unsigned nloc = b.st[0], nx = b.st[1];
        if (nloc == 0u) { xcd_barrier_complete(bar, b.x, nloc, nx); b.st[0] = nloc; b.st[1] = nx; }
        const unsigned old = xb_add(&bar[XB_XSUB(b.x)], 1u);
        const unsigned gen = old / nloc;
        if (old + 1u == (gen + 1u) * nloc) {
            __builtin_amdgcn_fence(__ATOMIC_RELEASE, "agent");
            asm volatile("s_waitcnt vmcnt(0)" ::: "memory");
            const unsigned og = xb_add(&bar[XB_TOP], 1u);
            const unsigned tg = og / nx;
            if (og + 1u == (tg + 1u) * nx) xb_add(&bar[XB_TOPGEN], 1u);
            else XB_SPIN(xb_ld(&bar[XB_TOPGEN]) == tg, bar);
            __builtin_amdgcn_fence(__ATOMIC_ACQUIRE, "agent");
            xb_add(&bar[XB_XGEN(b.x)], 1u);
            asm volatile("s_waitcnt vmcnt(0)" ::: "memory");
        } else {
            XB_SPIN(xb_ld(&bar[XB_XGEN(b.x)]) == gen, bar);
            __builtin_amdgcn_fence(__ATOMIC_ACQUIRE, "agent");
            asm volatile("s_waitcnt vmcnt(0)" ::: "memory");
        }
    }
    __syncthreads();
}

namespace mb {
constexpr int D = 128; constexpr float THR = 8.f; constexpr bool WSKIP = false;
typedef short bf16x8 __attribute__((ext_vector_type(8)));
typedef short s16x4 __attribute__((ext_vector_type(4)));
typedef float f32x16 __attribute__((ext_vector_type(16)));
typedef float f32x4 __attribute__((ext_vector_type(4)));
typedef unsigned u32x4 __attribute__((ext_vector_type(4)));
template <class A, class Bt> struct same_t { static constexpr bool v = false; };
template <class A> struct same_t<A, A> { static constexpr bool v = true; };
constexpr float SCALE = 0.08838834764831845f;
constexpr int NW = 8, QBLK = 32, KVBLK = 64, QB = NW * QBLK;
constexpr int SHM_V = KVBLK * D * 2, SHM_K = KVBLK * D * 2;
constexpr int ATT_LDS_BYTES = 2 * SHM_V + 2 * SHM_K + NW * 64 * 4;

#define KSWZ(row, colB) ((row) * 256 + ((colB) ^ (((row) & 7) << 4)))
#define SBAR() __builtin_amdgcn_sched_barrier(0)
__device__ __forceinline__ int v_st(int k, int c) { const int kk = (k & ~0xC) | ((k & 4) << 1) | ((k & 8) >> 1); return ((kk >> 3) * 4 + (c >> 5)) * 512 + ((kk & 7) * 32 + (c & 31)) * 2; }
__device__ __forceinline__ int v_rd_base(int lane) { return ((lane & 3) << 3) | (((lane >> 2) & 3) << 6) | (((lane >> 4) & 1) << 5) | (((lane >> 5) & 1) << 8); }
constexpr int v_rd_off(int d0, int ks, int half) { return d0 * 512 + ks * 4096 + half * 2048; }
__device__ __forceinline__ int crow(int r, int hi) { return (r & 3) + 8 * (r >> 2) + 4 * hi; }
__device__ __forceinline__ unsigned cvtpk(float lo, float hi) {
    unsigned r; asm volatile("v_cvt_pk_bf16_f32 %0, %1, %2" : "=v"(r) : "v"(lo), "v"(hi)); return r;
}
__device__ __forceinline__ bf16x8 pack8(f32x4 a, f32x4 b) {
    u32x4 w = {cvtpk(a[0], a[1]), cvtpk(a[2], a[3]), cvtpk(b[0], b[1]), cvtpk(b[2], b[3])};
    return *reinterpret_cast<bf16x8*>(&w);
}
template <class T> __device__ __forceinline__ bf16x8 load8(const T* p) {
    if constexpr (same_t<T, float>::v) { return pack8(*(const f32x4*)p, *(const f32x4*)(p + 4)); }
    else { return *reinterpret_cast<const bf16x8*>(p); }
}
__device__ __forceinline__ void mask_tile(f32x16& p0, f32x16& p1, int dq, unsigned W) {
    const float NEG = -__builtin_inff();
#pragma unroll
    for (int r = 0; r < 16; ++r) {
        const int c = (r & 3) + 8 * (r >> 2);
        if ((unsigned)(dq - c) >= W) p0[r] = NEG;
        if ((unsigned)(dq - c - 32) >= W) p1[r] = NEG;
    }
}
__device__ __forceinline__ void blk_mask(f32x16& p0, f32x16& p1, unsigned keep) {
    const float NEG = -__builtin_inff();
#pragma unroll
    for (int r = 0; r < 16; ++r) { p0[r] = keep ? p0[r] : NEG; p1[r] = keep ? p1[r] : NEG; }
}
__device__ __forceinline__ void partialSM(f32x16& p0, f32x16& p1, float& m_reg, float& mn, float& alpha) {
    float pmax = p0[0]; for (int r = 1; r < 16; ++r) pmax = fmaxf(pmax, p0[r]); for (int r = 0; r < 16; ++r) pmax = fmaxf(pmax, p1[r]);
    { auto rr = __builtin_amdgcn_permlane32_swap(__float_as_uint(pmax), __float_as_uint(pmax), false, false);
      pmax = fmaxf(__uint_as_float(rr[0]), __uint_as_float(rr[1])); }
    constexpr float C2 = 1.4426950408889634f * SCALE;
    if (__builtin_expect(__all((pmax - m_reg) * SCALE <= THR), 1)) { mn = m_reg; alpha = 1.f; }
    else { mn = fmaxf(m_reg, pmax); alpha = __builtin_amdgcn_exp2f((m_reg - mn) * C2); m_reg = mn; }
    const float mnL = -mn * C2;
    for (int r = 0; r < 16; ++r) p0[r] = fmaf(p0[r], C2, mnL); for (int r = 0; r < 16; ++r) p1[r] = fmaf(p1[r], C2, mnL);
    for (int r = 0; r < 16; ++r) p0[r] = __builtin_amdgcn_exp2f(p0[r]);
}
__device__ __forceinline__ void finishSM(f32x16& p0, f32x16& p1, float alpha, float& l_reg, bf16x8& pa0, bf16x8& pa1, bf16x8& pa2, bf16x8& pa3) {
    for (int r = 0; r < 16; ++r) p1[r] = __builtin_amdgcn_exp2f(p1[r]);
    float ps = 0; for (int r = 0; r < 16; ++r) ps += p0[r]; for (int r = 0; r < 16; ++r) ps += p1[r];
    { auto rr = __builtin_amdgcn_permlane32_swap(__float_as_uint(ps), __float_as_uint(ps), false, false);
      ps = __uint_as_float(rr[0]) + __uint_as_float(rr[1]); }
    l_reg = l_reg * alpha + ps;
#define PK4(P, B_, OUT) do { unsigned a0 = cvtpk(P[B_+0], P[B_+1]), a1 = cvtpk(P[B_+2], P[B_+3]);                          \
        unsigned b0 = cvtpk(P[B_+4], P[B_+5]), b1 = cvtpk(P[B_+6], P[B_+7]);                                             \
        auto r0 = __builtin_amdgcn_permlane32_swap(a0, b0, false, false); auto r1 = __builtin_amdgcn_permlane32_swap(a1, b1, false, false); \
        u32x4 w = {r0[0], r1[0], r0[1], r1[1]}; OUT = *reinterpret_cast<bf16x8*>(&w); } while (0)
    PK4(p0, 0, pa0); PK4(p0, 8, pa1); PK4(p1, 0, pa2); PK4(p1, 8, pa3);
#undef PK4
}
template <int KB, bool SK>
__device__ __forceinline__ void qkt(f32x16& p0, f32x16& p1, const char* K_lds, int r32, int hi, const bf16x8* qr, bool act) {
    if (SK && !act) { const float NEG = -__builtin_inff();
#pragma unroll
        for (int r = 0; r < 16; ++r) { p0[r] = NEG; p1[r] = NEG; } return; }
    p0 = f32x16{}; p1 = f32x16{};
    const char* kb[4];
#pragma unroll
    for (int dd = 0; dd < 4; ++dd) kb[dd] = K_lds + KB * SHM_K + KSWZ(r32, (dd * 16 + hi * 8) * 2);
#pragma unroll
    for (int d0 = 0; d0 < 8; ++d0) { const char* a = kb[d0 & 3] + (d0 >> 2) * 128;
        bf16x8 b0 = *reinterpret_cast<const bf16x8*>(a);
        bf16x8 b1 = *reinterpret_cast<const bf16x8*>(a + 32 * 256);
        p0 = __builtin_amdgcn_mfma_f32_32x32x16_bf16(b0, qr[d0], p0, 0, 0, 0);
        p1 = __builtin_amdgcn_mfma_f32_32x32x16_bf16(b1, qr[d0], p1, 0, 0, 0); }
}
template <int VB, bool SK>
__device__ __forceinline__ void pv_tile(f32x16* o, int vb0, bf16x8 pa0, bf16x8 pa1, bf16x8 pa2, bf16x8 pa3, bool act) {
    if (SK && !act) return;
#define TRRD(dst, off) asm volatile("ds_read_b64_tr_b16 %0, %1 offset:%2" : "=&v"(dst) : "v"(vb0), "i"(off) : "memory")
#define PV_D0(d0) do { s16x4 l0, l1, l2, l3, h0, h1, h2, h3; constexpr int b_ = VB * SHM_V + v_rd_off(d0, 0, 0);     \
        TRRD(l0, b_); TRRD(h0, b_ + 2048); TRRD(l1, b_ + 4096); TRRD(h1, b_ + 6144); TRRD(l2, b_ + 8192); TRRD(h2, b_ + 10240); TRRD(l3, b_ + 12288); TRRD(h3, b_ + 14336); \
        asm volatile("s_waitcnt lgkmcnt(0)" ::: "memory"); SBAR();                 \
        o[d0] = __builtin_amdgcn_mfma_f32_32x32x16_bf16(pa0, (bf16x8){l0[0], l0[1], l0[2], l0[3], h0[0], h0[1], h0[2], h0[3]}, o[d0], 0, 0, 0);   \
        o[d0] = __builtin_amdgcn_mfma_f32_32x32x16_bf16(pa1, (bf16x8){l1[0], l1[1], l1[2], l1[3], h1[0], h1[1], h1[2], h1[3]}, o[d0], 0, 0, 0);   \
        o[d0] = __builtin_amdgcn_mfma_f32_32x32x16_bf16(pa2, (bf16x8){l2[0], l2[1], l2[2], l2[3], h2[0], h2[1], h2[2], h2[3]}, o[d0], 0, 0, 0);   \
        o[d0] = __builtin_amdgcn_mfma_f32_32x32x16_bf16(pa3, (bf16x8){l3[0], l3[1], l3[2], l3[3], h3[0], h3[1], h3[2], h3[3]}, o[d0], 0, 0, 0); } while (0)
    PV_D0(0); PV_D0(1); PV_D0(2); PV_D0(3);
#undef PV_D0
#undef TRRD
}

template <class TIn, class TOut> struct BlockRef { const TIn* Q; const TIn* K; const TIn* V; TOut* O; int P0; int bh; };
template <class TIn> struct Seam {
    bf16x8 qr[8];
    bf16x8 st_v0, st_v1, st_k0, st_k1; f32x4 sf0, sf1, sf2, sf3;
    f32x4 tq[16];
};
__device__ __forceinline__ int swa_jlo(int P0, int W) { const int lowk = P0 - W + 1; return lowk > 0 ? lowk / KVBLK : 0; }
#define ROW(p, k0, rr) ((p) + (size_t)((k0) + (rr)) * D + sc)
#define VMW() asm volatile("s_waitcnt vmcnt(0)" ::: "memory")
#define VMWN(n) asm volatile("s_waitcnt vmcnt(%0)" :: "i"(n) : "memory")
#define SLOAD_H(Kp, Vp, k0) do { S.st_v0 = load8<TIn>(ROW(Vp, k0, sr)); S.st_v1 = load8<TIn>(ROW(Vp, k0, 32 + sr));              \
                         S.st_k0 = load8<TIn>(ROW(Kp, k0, sr)); S.st_k1 = load8<TIn>(ROW(Kp, k0, 32 + sr)); } while (0)
#define SWRITE_HK(bf) do { *(bf16x8*)(K_lds + (bf) * SHM_K + kws) = S.st_k0; *(bf16x8*)(K_lds + (bf) * SHM_K + kws + 32 * 256) = S.st_k1; } while (0)
#define SWRITE_HV(bf) do { *(bf16x8*)(V_lds + (bf) * SHM_V + vst0) = S.st_v0; *(bf16x8*)(V_lds + (bf) * SHM_V + vst1) = S.st_v1; } while (0)
#define SWRITE_H(bf) do { SWRITE_HV(bf); SWRITE_HK(bf); } while (0)
#define SLOAD_F(p, k0) do { S.sf0 = *(const f32x4*)ROW(p, k0, sr); S.sf1 = *(const f32x4*)(ROW(p, k0, sr) + 4);                \
                            S.sf2 = *(const f32x4*)ROW(p, k0, 32 + sr); S.sf3 = *(const f32x4*)(ROW(p, k0, 32 + sr) + 4); } while (0)
#define SWRITE_KF(bf) do { *(bf16x8*)(K_lds + (bf) * SHM_K + kws) = pack8(S.sf0, S.sf1); *(bf16x8*)(K_lds + (bf) * SHM_K + kws + 32 * 256) = pack8(S.sf2, S.sf3); } while (0)
#define SWRITE_VF(bf) do { *(bf16x8*)(V_lds + (bf) * SHM_V + vst0) = pack8(S.sf0, S.sf1); *(bf16x8*)(V_lds + (bf) * SHM_V + vst1) = pack8(S.sf2, S.sf3); } while (0)
template <class TIn, class TOut>
__device__ __forceinline__ void causal_swa_prime(const BlockRef<TIn, TOut>& cur, int W, char* lds, Seam<TIn>& S) {
    constexpr bool F32 = same_t<TIn, float>::v;
    const int tid = threadIdx.x, wid = __builtin_amdgcn_readfirstlane(tid >> 6), lane = tid & 63, r32 = lane & 31, hi = lane >> 5;
    const int sr = tid >> 4, sc = (tid & 15) * 8, kws = KSWZ(sr, sc * 2); char* K_lds = lds + 2 * SHM_V;
    const int kb0 = swa_jlo(cur.P0, W) * KVBLK;
    for (int d0 = 0; d0 < 8; ++d0) S.qr[d0] = load8<TIn>(cur.Q + (size_t)(wid * QBLK + r32) * D + d0 * 16 + hi * 8);
    if constexpr (F32) { SLOAD_F((const float*)cur.K, kb0); VMW(); SWRITE_KF(0); SBAR(); SLOAD_F((const float*)cur.V, kb0); }
    else { SLOAD_H(cur.K, cur.V, kb0); VMW(); SWRITE_HK(0); }
    __syncthreads();
}
template <class TIn, class TOut>
__device__ __forceinline__ void causal_swa_block(const BlockRef<TIn, TOut>& cur, const BlockRef<TIn, TOut>& nxt, int skv, int W, char* lds, Seam<TIn>& S, const float* ksum) {
    constexpr bool F32 = same_t<TIn, float>::v;
    const int tid = threadIdx.x, wid = __builtin_amdgcn_readfirstlane(tid >> 6), lane = tid & 63, r32 = lane & 31, hi = lane >> 5;
    const int j_lo = swa_jlo(cur.P0, W);
    const int qb = cur.P0 >> 8; unsigned selm = 0xffu;
    if (qb > 3) {
        f32x16 g = f32x16{};
        const float* kp = ksum + ((size_t)((cur.bh >> 2) * 8 + (r32 & 7)) * 2) * 512 + (cur.bh & 3) * 128 + hi * 8;
#pragma unroll
        for (int d0 = 0; d0 < 8; ++d0) { const f32x4 a0 = *(const f32x4*)(kp + d0 * 16) + *(const f32x4*)(kp + 512 + d0 * 16), a1 = *(const f32x4*)(kp + d0 * 16 + 4) + *(const f32x4*)(kp + 512 + d0 * 16 + 4);
            u32x4 wh = {cvtpk(a0[0], a0[1]), cvtpk(a0[2], a0[3]), cvtpk(a1[0], a1[1]), cvtpk(a1[2], a1[3])};
            f32x4 r0 = {a0[0] - __uint_as_float(wh[0] << 16), a0[1] - __uint_as_float(wh[0] & 0xffff0000u), a0[2] - __uint_as_float(wh[1] << 16), a0[3] - __uint_as_float(wh[1] & 0xffff0000u)};
            f32x4 r1 = {a1[0] - __uint_as_float(wh[2] << 16), a1[1] - __uint_as_float(wh[2] & 0xffff0000u), a1[2] - __uint_as_float(wh[3] << 16), a1[3] - __uint_as_float(wh[3] & 0xffff0000u)};
            u32x4 wl = {cvtpk(r0[0], r0[1]), cvtpk(r0[2], r0[3]), cvtpk(r1[0], r1[1]), cvtpk(r1[2], r1[3])};
            g = __builtin_amdgcn_mfma_f32_32x32x16_bf16(*reinterpret_cast<bf16x8*>(&wh), S.qr[d0], g, 0, 0, 0);
            g = __builtin_amdgcn_mfma_f32_32x32x16_bf16(*reinterpret_cast<bf16x8*>(&wl), S.qr[d0], g, 0, 0, 0); }
        float gv[8];
#pragma unroll
        for (int j = 0; j < 4; ++j) { const float own = g[j], oth = __shfl_xor(own, 32); gv[j] = hi ? oth : own; gv[j + 4] = hi ? own : oth; }
        selm = 0u;
#pragma unroll
        for (int j = 0; j < 8; ++j) { int rank = 0;
#pragma unroll
            for (int k = 0; k < 8; ++k) if (k < qb && (gv[k] > gv[j] || (gv[k] == gv[j] && k < j))) ++rank;
            if (j < qb && rank < 3) selm |= 1u << j; }
    }
    int j_hi = (cur.P0 + QB - 1) / KVBLK + 1; if (j_hi > skv / KVBLK) j_hi = skv / KVBLK;
    const int NT = j_hi - j_lo;
    const int kbn = swa_jlo(nxt.P0, W) * KVBLK;
    const int qlo = cur.P0 + wid * QBLK, qm = qlo + r32 - 4 * hi;
    char* V_lds = lds; char* K_lds = lds + 2 * SHM_V;
    float* ws = (float*)(lds + 2 * SHM_V + 2 * SHM_K) + wid * 64; float* li_l = ws, * al_l = ws + 32;
    float m_reg = -1e30f, l_reg = 0; f32x16 o[4] = {};
    const int sr = tid >> 4, sc = (tid & 15) * 8, vst0 = v_st(sr, sc), vst1 = v_st(32 + sr, sc), kws = KSWZ(sr, sc * 2);
    const int vb0 = (int)(uintptr_t)V_lds + v_rd_base(lane);
    const TIn* Kh = cur.K; const TIn* Vh = cur.V;
#define RESC(a) do { if (__any((a) < 1.f)) { if (hi == 0) al_l[r32] = (a); asm volatile("s_waitcnt lgkmcnt(0)" ::: "memory");              \
                     for (int d_ = 0; d_ < 4; ++d_) for (int r = 0; r < 16; ++r) o[d_][r] *= al_l[crow(r, hi)]; } } while (0)
#define KBASE(t) ((j_lo + (t)) * KVBLK)
#define ACT(t) (KBASE(t) <= qlo + QBLK - 1 && KBASE(t) + KVBLK - 1 >= qlo - W + 1)
#define MASKT(P0_, P1_, t) do { const int kb_ = KBASE(t); if ((!SK || ACT(t)) && (kb_ + KVBLK - 1 > qlo || kb_ <= qlo + QBLK - 1 - W)) mask_tile(P0_, P1_, qm - kb_, (unsigned)W); if (qb > 3 && kb_ < cur.P0) blk_mask(P0_, P1_, (selm >> (kb_ >> 8)) & 1u); } while (0)
    constexpr int NQL = F32 ? 16 : 8;
    constexpr bool SK = WSKIP && !F32;
#define SEAM_K0() do { VMWN(NQL); if constexpr (F32) { SWRITE_KF(0); SBAR(); SLOAD_F((const float*)nxt.V, kbn); } else { SWRITE_HK(0); } SBAR(); } while (0)
    f32x16 pA0, pA1, pB0, pB1; float mnA, mnB, alA, alB; bf16x8 pa0, pa1, pa2, pa3;
    if constexpr (F32) { VMW(); SWRITE_VF(0); SBAR(); } else { SWRITE_HV(0); SBAR(); }
    if (NT > 1) { if constexpr (F32) SLOAD_F((const float*)Kh, KBASE(1)); else SLOAD_H(Kh, Vh, KBASE(1)); }
    SBAR(); qkt<0, SK>(pA0, pA1, K_lds, r32, hi, S.qr, ACT(0));
    if constexpr (F32) { if (NT > 1) { VMW(); SWRITE_KF(1); SBAR(); SLOAD_F((const float*)Vh, KBASE(1)); } }
    MASKT(pA0, pA1, 0); partialSM(pA0, pA1, m_reg, mnA, alA);
    if (NT > 1) { VMW(); if constexpr (F32) { SWRITE_VF(1); SBAR(); if (NT > 2) SLOAD_F((const float*)Kh, KBASE(2)); } else SWRITE_H(1); }
    __syncthreads();
#define HALF_STEP(PX0, PX1, mnX, alX, PY0, PY1, alY, t, KB, VB, SB) do {                                                      \
        SBAR(); qkt<KB, SK>(PX0, PX1, K_lds, r32, hi, S.qr, ACT(t));                                             \
        finishSM(PY0, PY1, alY, l_reg, pa0, pa1, pa2, pa3); SBAR();                                                           \
        if ((t) + 1 < NT) { if constexpr (F32) { VMW(); SWRITE_KF(SB); SBAR(); SLOAD_F((const float*)Vh, KBASE((t) + 1)); }  \
                            else { SLOAD_H(Kh, Vh, KBASE((t) + 1)); } SBAR(); }                                               \
        pv_tile<VB, SK>(o, vb0, pa0, pa1, pa2, pa3, ACT((t) - 1)); MASKT(PX0, PX1, (t)); partialSM(PX0, PX1, m_reg, mnX, alX);                                        \
        __syncthreads();                                                                                                      \
        if ((t) + 1 < NT) { VMW(); if constexpr (F32) { SWRITE_VF(SB); SBAR(); if ((t) + 2 < NT) SLOAD_F((const float*)Kh, KBASE((t) + 2)); } \
                            else { SWRITE_H(SB); } }                                                                          \
        RESC(alX); __syncthreads(); } while (0)
    for (int t = 1; t + 1 < NT; t += 2) {
        HALF_STEP(pB0, pB1, mnB, alB, pA0, pA1, alA, t, 1, 0, 0);
        HALF_STEP(pA0, pA1, mnA, alA, pB0, pB1, alB, t + 1, 0, 1, 1);
    }
    const bool even = (NT & 1) == 0;
    if (even) { SBAR(); qkt<1, SK>(pB0, pB1, K_lds, r32, hi, S.qr, ACT(NT - 1)); SBAR(); }
#define QROW(e) (nxt.Q + (size_t)(wid * QBLK + r32) * D + ((e) >> 1) * 16 + hi * 8 + ((e) & 1) * 4)
    if constexpr (F32) { SLOAD_F((const float*)nxt.K, kbn); SBAR();
#pragma unroll
        for (int e = 0; e < 8; ++e) S.tq[e] = *(const f32x4*)QROW(e); }
    else { SLOAD_H(nxt.K, nxt.V, kbn); SBAR();
#pragma unroll
        for (int d0 = 0; d0 < 8; ++d0) S.qr[d0] = load8<TIn>(nxt.Q + (size_t)(wid * QBLK + r32) * D + d0 * 16 + hi * 8); }
    SBAR();
    finishSM(pA0, pA1, alA, l_reg, pa0, pa1, pa2, pa3); SBAR();
    if constexpr (F32) {
#pragma unroll
        for (int e = 8; e < 16; ++e) S.tq[e] = *(const f32x4*)QROW(e); SBAR(); }
#undef QROW
    pv_tile<0, SK>(o, vb0, pa0, pa1, pa2, pa3, ACT(even ? NT - 2 : NT - 1));
    if (even) { MASKT(pB0, pB1, NT - 1); partialSM(pB0, pB1, m_reg, mnB, alB); __syncthreads(); RESC(alB);
        finishSM(pB0, pB1, alB, l_reg, pa0, pa1, pa2, pa3); SBAR(); pv_tile<1, SK>(o, vb0, pa0, pa1, pa2, pa3, ACT(NT - 1)); }
    SBAR(); SEAM_K0();
    if (hi == 0) li_l[r32] = l_reg; asm volatile("s_waitcnt lgkmcnt(0)" ::: "memory");
    float rli[16];
#pragma unroll
    for (int r = 0; r < 16; ++r) { const float rl = __builtin_amdgcn_rcpf(li_l[crow(r, hi)]);
        float q = 0.f;
#pragma unroll
        for (int d0 = 0; d0 < 4; ++d0) { const float v = o[d0][r] * rl; q += v * v; }
#pragma unroll
        for (int x = 1; x < 32; x <<= 1) q += __shfl_xor(q, x);
        rli[r] = rl * rsqrtf(q * (1.f / 128.f) + 1e-6f); }
    char* Ow = (char*)(cur.O + ((size_t)(cur.bh >> 2) * 2048 + cur.P0 + wid * QBLK) * 1024 + 512 + (cur.bh & 3) * 128);
    unsigned oo = (unsigned)(hi * 4 * 2048 + r32 * 2);
#pragma unroll
    for (int r = 0; r < 16; ++r) {
#pragma unroll
        for (int d0 = 0; d0 < 4; ++d0) { const float v = o[d0][r] * rli[r];
            const float vn = __shfl_xor(v, 1);
            if ((r32 & 1) == 0) *(unsigned*)(Ow + oo + d0 * 64) = cvtpk(v, vn); }
        oo += ((r & 3) == 3) ? 5 * 2048 : 2048; asm volatile("" : "+v"(oo)); }
    if constexpr (F32) {
#pragma unroll
        for (int d0 = 0; d0 < 8; ++d0) S.qr[d0] = pack8(S.tq[2 * d0], S.tq[2 * d0 + 1]); }
    __syncthreads();
#undef RESC
#undef KBASE
#undef ACT
#undef MASKT
#undef SEAM_K0
#undef HALF_STEP
}
#undef ROW
#undef VMW
#undef VMWN
#undef SLOAD_H
#undef SWRITE_HK
#undef SWRITE_HV
#undef SWRITE_H
#undef SLOAD_F
#undef SWRITE_KF
#undef SWRITE_VF

struct Item { int bh, qb0, qb1; };
__device__ __forceinline__ Item decode(int L) { Item it; const int xcd = L & 7, k = L >> 3, gi = k >> 2, x = k & 3; it.bh = gi * 8 + xcd; it.qb0 = x; it.qb1 = 7 - x; return it; }
__device__ __forceinline__ BlockRef<bf16, bf16> mkref(const Item& it, int pass, const bf16* Q, const bf16* K, const bf16* V, bf16* O) {
    const int qb = pass ? it.qb1 : it.qb0; BlockRef<bf16, bf16> r;
    r.Q = Q + ((size_t)it.bh * 2048 + (size_t)qb * QB) * D; r.K = K + (size_t)it.bh * 2048 * D; r.V = V + (size_t)it.bh * 2048 * D; r.O = O; r.P0 = qb * QB; r.bh = it.bh; return r;
}
__device__ __forceinline__ void moba_phase(char* lds, const bf16* Q, const bf16* K, const bf16* V, bf16* O, const float* ksum, int xcd, int k0, int cnt) {
    constexpr int W = 1 << 20;
    if (cnt <= 0) return;
    int kk = k0; Item it = decode(kk * 8 + xcd); int pass = 0;
    BlockRef<bf16, bf16> cur = mkref(it, 0, Q, K, V, O);
    Seam<bf16> S;
    causal_swa_prime<bf16, bf16>(cur, W, lds, S);
    for (;;) {
        const bool more_pass = pass == 0, more_item = kk + 1 < k0 + cnt, last = !more_pass && !more_item;
        Item itn = it; int passn = pass + 1, kn = kk;
        if (!more_pass) { passn = 0; kn = more_item ? kk + 1 : kk; itn = decode(kn * 8 + xcd); }
        const BlockRef<bf16, bf16> nxt = last ? cur : mkref(itn, passn, Q, K, V, O);
        causal_swa_block<bf16, bf16>(cur, nxt, 2048, W, lds, S, ksum);
        if (last) break;
        cur = nxt; it = itn; pass = passn; kk = kn;
    }
}
}

namespace gla {
typedef short bf16x8 __attribute__((ext_vector_type(8)));
typedef short s16x4 __attribute__((ext_vector_type(4)));
typedef float f32x16 __attribute__((ext_vector_type(16)));
typedef float f32x4 __attribute__((ext_vector_type(4)));
typedef unsigned u32x4 __attribute__((ext_vector_type(4)));
typedef unsigned u32x2 __attribute__((ext_vector_type(2)));
constexpr int L_QD = 0, L_KI = 8192, L_KE = 16384, L_V = 24576, L_ST = 40960, L_OST = 73728, L_DEC = 90112, GLA_LDS_BYTES = 90368;
constexpr float LOG2E = 1.4426950408889634f;
__device__ __forceinline__ int swz128(int row, int colB) { return row * 128 + (colB ^ (((row >> 1) & 7) << 4)); }
__device__ __forceinline__ int tr_st(int k, int c, int ncs) { const int kk = (k & ~0xC) | ((k & 4) << 1) | ((k & 8) >> 1); return ((kk >> 3) * ncs + (c >> 5)) * 512 + ((kk & 7) * 32 + (c & 31)) * 2; }
__device__ __forceinline__ int tr_rd_base(int lane) { return ((lane & 3) << 3) | (((lane >> 2) & 3) << 6) | (((lane >> 4) & 1) << 5) | (((lane >> 5) & 1) << 8); }
__device__ __forceinline__ int crow(int r, int hi) { return (r & 3) + 8 * (r >> 2) + 4 * hi; }
typedef float f32x2_t __attribute__((ext_vector_type(2))); typedef __bf16 bf16x2_t __attribute__((ext_vector_type(2)));
__device__ __forceinline__ unsigned cvtpk(float lo, float hi) { f32x2_t v = {lo, hi}; bf16x2_t b = __builtin_convertvector(v, bf16x2_t); return __builtin_bit_cast(unsigned, b); }
__device__ __forceinline__ float bflo(unsigned w) { return __uint_as_float(w << 16); }
__device__ __forceinline__ float bfhi(unsigned w) { return __uint_as_float(w & 0xffff0000u); }
#define GLA_SBAR() __builtin_amdgcn_sched_barrier(0)
#define GLA_TRRD(dst, addr, off) asm volatile("ds_read_b64_tr_b16 %0, %1 offset:%2" : "=&v"(dst) : "v"(addr), "i"(off) : "memory")
#define GLA_FRAG(l, h) (bf16x8){l[0], l[1], l[2], l[3], h[0], h[1], h[2], h[3]}
#define GLA_PK4(P, B_, OUT) do { unsigned a0 = cvtpk(P[B_+0], P[B_+1]), a1 = cvtpk(P[B_+2], P[B_+3]); unsigned b0 = cvtpk(P[B_+4], P[B_+5]), b1 = cvtpk(P[B_+6], P[B_+7]); \
        auto r0 = __builtin_amdgcn_permlane32_swap(a0, b0, false, false); auto r1 = __builtin_amdgcn_permlane32_swap(a1, b1, false, false); \
        u32x4 w = {r0[0], r1[0], r0[1], r1[1]}; OUT = *reinterpret_cast<bf16x8*>(&w); } while (0)

__device__ __forceinline__ void gla_unit(char* lds, int bh, const bf16* GQ, const bf16* GK, const bf16* GV, const float* GB, const bf16* GR, bf16* O) {
    const int tid = threadIdx.x, lane = tid & 63, r32 = lane & 31, hi = lane >> 5; const int wid = __builtin_amdgcn_readfirstlane(tid >> 6), dvt = wid & 3, half = wid >> 2;
    const int sc = tid >> 3, j8 = tid & 7;
    const bf16* qp = GQ + ((size_t)bh * SEQ + sc) * 64 + j8 * 8; const bf16* kp = GK + ((size_t)bh * SEQ + sc) * 64 + j8 * 8;
    const float* bp = GB + ((size_t)bh * SEQ + sc) * 64 + j8 * 8; const float* blp = GB + ((size_t)bh * SEQ + 63) * 64 + j8 * 8;
    const bf16* vp = GV + ((size_t)bh * SEQ + sc) * 128 + j8 * 16;
    const size_t t0 = (size_t)(bh >> 2) * SEQ; const int hcol = (bh & 3) * 128 + j8 * 16;
    const bf16* grp = GR + (t0 + sc) * 512 + hcol; bf16* op = O + (t0 + sc) * DM + hcol;
    const int ldsb = (int)(uintptr_t)lds;
    const int vtr = ldsb + L_V + tr_rd_base(lane) + dvt * 512, ketr = ldsb + L_KE + tr_rd_base(lane) + half * 512;
    const int w_qd = swz128(sc, j8 * 16), w_ke = tr_st(sc, j8 * 8, 2), w_v0 = tr_st(sc, j8 * 16, 4), w_v1 = tr_st(sc, j8 * 16 + 8, 4);
    { u32x4 z = {0u, 0u, 0u, 0u}; *(u32x4*)(lds + L_ST + tid * 32) = z; *(u32x4*)(lds + L_ST + tid * 32 + 16) = z; }
    f32x16 S = f32x16{};
    u32x4 sq = *(const u32x4*)qp, sk = *(const u32x4*)kp, sv0 = *(const u32x4*)vp, sv1 = *(const u32x4*)(vp + 8);
    f32x4 sb0 = *(const f32x4*)bp, sb1 = *(const f32x4*)(bp + 4), sl0 = *(const f32x4*)blp, sl1 = *(const f32x4*)(blp + 4);
    for (int n = 0; n < 32; ++n) {
        const int p = n & 1;
        { float q[8], k[8], b2[8], l2[8];
            q[0] = bflo(sq.x); q[1] = bfhi(sq.x); q[2] = bflo(sq.y); q[3] = bfhi(sq.y); q[4] = bflo(sq.z); q[5] = bfhi(sq.z); q[6] = bflo(sq.w); q[7] = bfhi(sq.w);
            k[0] = bflo(sk.x); k[1] = bfhi(sk.x); k[2] = bflo(sk.y); k[3] = bfhi(sk.y); k[4] = bflo(sk.z); k[5] = bfhi(sk.z); k[6] = bflo(sk.w); k[7] = bfhi(sk.w);
#pragma unroll
            for (int i = 0; i < 4; ++i) { b2[i] = sb0[i] * LOG2E; b2[4 + i] = sb1[i] * LOG2E; l2[i] = sl0[i] * LOG2E; l2[4 + i] = sl1[i] * LOG2E; }
            float qd[8], ki[8], ke[8];
#pragma unroll
            for (int i = 0; i < 8; ++i) { qd[i] = q[i] * 0.125f * __builtin_amdgcn_exp2f(b2[i]); ki[i] = k[i] * __builtin_amdgcn_exp2f(-b2[i]); ke[i] = k[i] * __builtin_amdgcn_exp2f(l2[i] - b2[i]); }
            u32x4 w;
            w.x = cvtpk(qd[0], qd[1]); w.y = cvtpk(qd[2], qd[3]); w.z = cvtpk(qd[4], qd[5]); w.w = cvtpk(qd[6], qd[7]); *(u32x4*)(lds + L_QD + w_qd) = w;
            w.x = cvtpk(ki[0], ki[1]); w.y = cvtpk(ki[2], ki[3]); w.z = cvtpk(ki[4], ki[5]); w.w = cvtpk(ki[6], ki[7]); *(u32x4*)(lds + L_KI + w_qd) = w;
            w.x = cvtpk(ke[0], ke[1]); w.y = cvtpk(ke[2], ke[3]); w.z = cvtpk(ke[4], ke[5]); w.w = cvtpk(ke[6], ke[7]); *(u32x4*)(lds + L_KE + w_ke) = w;
            *(u32x4*)(lds + L_V + w_v0) = sv0; *(u32x4*)(lds + L_V + w_v1) = sv1;
            if (sc == 0) { f32x4 d0, d1;
#pragma unroll
                for (int i = 0; i < 4; ++i) { d0[i] = __builtin_amdgcn_exp2f(l2[i]); d1[i] = __builtin_amdgcn_exp2f(l2[4 + i]); }
                *(f32x4*)(lds + L_DEC + j8 * 32) = d0; *(f32x4*)(lds + L_DEC + j8 * 32 + 16) = d1; } }
        const u32x4 g0 = *(const u32x4*)(grp + (size_t)n * 64 * 512), g1 = *(const u32x4*)(grp + (size_t)n * 64 * 512 + 8);
        if (n + 1 < 32) { const size_t o64 = (size_t)(n + 1) * 64 * 64, o128 = (size_t)(n + 1) * 64 * 128;
            sq = *(const u32x4*)(qp + o64); sk = *(const u32x4*)(kp + o64); sv0 = *(const u32x4*)(vp + o128); sv1 = *(const u32x4*)(vp + o128 + 8);
            sb0 = *(const f32x4*)(bp + o64); sb1 = *(const f32x4*)(bp + o64 + 4); sl0 = *(const f32x4*)(blp + o64); sl1 = *(const f32x4*)(blp + o64 + 4); }
        __syncthreads();
        {
            bf16x8 qf[4];
#pragma unroll
            for (int ks = 0; ks < 4; ++ks) qf[ks] = *(const bf16x8*)(lds + L_QD + swz128(half * 32 + r32, ks * 32 + hi * 16));
            f32x16 X0 = f32x16{}, X1 = f32x16{};
#pragma unroll
            for (int ks = 0; ks < 4; ++ks) X0 = __builtin_amdgcn_mfma_f32_32x32x16_bf16(*(const bf16x8*)(lds + L_KI + swz128(r32, ks * 32 + hi * 16)), qf[ks], X0, 0, 0, 0);
            if (half) {
#pragma unroll
                for (int ks = 0; ks < 4; ++ks) X1 = __builtin_amdgcn_mfma_f32_32x32x16_bf16(*(const bf16x8*)(lds + L_KI + swz128(32 + r32, ks * 32 + hi * 16)), qf[ks], X1, 0, 0, 0);
#pragma unroll
                for (int r = 0; r < 16; ++r) X1[r] = (crow(r, hi) <= r32) ? X1[r] : 0.f;
            } else {
#pragma unroll
                for (int r = 0; r < 16; ++r) X0[r] = (crow(r, hi) <= r32) ? X0[r] : 0.f;
            }
            bf16x8 pa0, pa1, pa2, pa3;
            GLA_PK4(X0, 0, pa0); GLA_PK4(X0, 8, pa1); GLA_PK4(X1, 0, pa2); GLA_PK4(X1, 8, pa3);
            s16x4 vl0, vh0, vl1, vh1, vl2, vh2, vl3, vh3, kl0, kh0, kl1, kh1, kl2, kh2, kl3, kh3;
            GLA_TRRD(vl0, vtr, 0); GLA_TRRD(vh0, vtr, 2048); GLA_TRRD(vl1, vtr, 4096); GLA_TRRD(vh1, vtr, 6144); GLA_TRRD(vl2, vtr, 8192); GLA_TRRD(vh2, vtr, 10240); GLA_TRRD(vl3, vtr, 12288); GLA_TRRD(vh3, vtr, 14336);
            GLA_TRRD(kl0, ketr, 0); GLA_TRRD(kh0, ketr, 1024); GLA_TRRD(kl1, ketr, 2048); GLA_TRRD(kh1, ketr, 3072); GLA_TRRD(kl2, ketr, 4096); GLA_TRRD(kh2, ketr, 5120); GLA_TRRD(kl3, ketr, 6144); GLA_TRRD(kh3, ketr, 7168);
            bf16x8 bs[4];
#pragma unroll
            for (int ks = 0; ks < 4; ++ks) bs[ks] = *(const bf16x8*)(lds + L_ST + p * 16384 + swz128(dvt * 32 + r32, ks * 32 + hi * 16));
            float dec[16];
#pragma unroll
            for (int r = 0; r < 16; ++r) dec[r] = *(const float*)(lds + L_DEC + (half * 32 + crow(r, hi)) * 4);
            asm volatile("s_waitcnt lgkmcnt(0)" ::: "memory"); GLA_SBAR();
            f32x16 o = f32x16{};
            o = __builtin_amdgcn_mfma_f32_32x32x16_bf16(pa0, GLA_FRAG(vl0, vh0), o, 0, 0, 0);
            o = __builtin_amdgcn_mfma_f32_32x32x16_bf16(pa1, GLA_FRAG(vl1, vh1), o, 0, 0, 0);
            if (half) { o = __builtin_amdgcn_mfma_f32_32x32x16_bf16(pa2, GLA_FRAG(vl2, vh2), o, 0, 0, 0); o = __builtin_amdgcn_mfma_f32_32x32x16_bf16(pa3, GLA_FRAG(vl3, vh3), o, 0, 0, 0); }
#pragma unroll
            for (int ks = 0; ks < 4; ++ks) o = __builtin_amdgcn_mfma_f32_32x32x16_bf16(qf[ks], bs[ks], o, 0, 0, 0);
#pragma unroll
            for (int r = 0; r < 16; ++r) S[r] *= dec[r];
            S = __builtin_amdgcn_mfma_f32_32x32x16_bf16(GLA_FRAG(kl0, kh0), GLA_FRAG(vl0, vh0), S, 0, 0, 0);
            S = __builtin_amdgcn_mfma_f32_32x32x16_bf16(GLA_FRAG(kl1, kh1), GLA_FRAG(vl1, vh1), S, 0, 0, 0);
            S = __builtin_amdgcn_mfma_f32_32x32x16_bf16(GLA_FRAG(kl2, kh2), GLA_FRAG(vl2, vh2), S, 0, 0, 0);
            S = __builtin_amdgcn_mfma_f32_32x32x16_bf16(GLA_FRAG(kl3, kh3), GLA_FRAG(vl3, vh3), S, 0, 0, 0);
#pragma unroll
            for (int r = 0; r < 16; ++r) *(unsigned short*)(lds + L_OST + (half * 32 + crow(r, hi)) * 256 + (dvt * 32 + r32) * 2) = (unsigned short)(cvtpk(o[r], 0.f) & 0xffffu);
#pragma unroll
            for (int g = 0; g < 4; ++g) { u32x2 w2; w2.x = cvtpk(S[4 * g], S[4 * g + 1]); w2.y = cvtpk(S[4 * g + 2], S[4 * g + 3]);
                *(u32x2*)(lds + L_ST + (p ^ 1) * 16384 + swz128(dvt * 32 + r32, (half * 32 + 8 * g + 4 * hi) * 2)) = w2; }
        }
        __syncthreads();
        { const u32x4 a = *(const u32x4*)(lds + L_OST + sc * 256 + j8 * 32), b = *(const u32x4*)(lds + L_OST + sc * 256 + j8 * 32 + 16);
            float v[16];
            v[0] = bflo(a.x); v[1] = bfhi(a.x); v[2] = bflo(a.y); v[3] = bfhi(a.y); v[4] = bflo(a.z); v[5] = bfhi(a.z); v[6] = bflo(a.w); v[7] = bfhi(a.w);
            v[8] = bflo(b.x); v[9] = bfhi(b.x); v[10] = bflo(b.y); v[11] = bfhi(b.y); v[12] = bflo(b.z); v[13] = bfhi(b.z); v[14] = bflo(b.w); v[15] = bfhi(b.w);
            float ss = 0.f;
#pragma unroll
            for (int i = 0; i < 16; ++i) ss += v[i] * v[i];
            ss += __shfl_xor(ss, 1); ss += __shfl_xor(ss, 2); ss += __shfl_xor(ss, 4);
            const float rs = rsqrtf(ss * (1.f / 128.f) + EPS);
            float g[16];
            g[0] = bflo(g0.x); g[1] = bfhi(g0.x); g[2] = bflo(g0.y); g[3] = bfhi(g0.y); g[4] = bflo(g0.z); g[5] = bfhi(g0.z); g[6] = bflo(g0.w); g[7] = bfhi(g0.w);
            g[8] = bflo(g1.x); g[9] = bfhi(g1.x); g[10] = bflo(g1.y); g[11] = bfhi(g1.y); g[12] = bflo(g1.z); g[13] = bfhi(g1.z); g[14] = bflo(g1.w); g[15] = bfhi(g1.w);
#pragma unroll
            for (int i = 0; i < 16; ++i) v[i] = v[i] * rs * g[i];
            u32x4 w0, w1;
            w0.x = cvtpk(v[0], v[1]); w0.y = cvtpk(v[2], v[3]); w0.z = cvtpk(v[4], v[5]); w0.w = cvtpk(v[6], v[7]);
            w1.x = cvtpk(v[8], v[9]); w1.y = cvtpk(v[10], v[11]); w1.z = cvtpk(v[12], v[13]); w1.w = cvtpk(v[14], v[15]);
            bf16* orow = op + (size_t)n * 64 * DM; *(u32x4*)orow = w0; *(u32x4*)(orow + 8) = w1; }
    }
    __syncthreads();
}
#undef GLA_SBAR
#undef GLA_TRRD
#undef GLA_FRAG
#undef GLA_PK4
}

constexpr int RING_OFF = 0, RING_BYTES = 131072;
constexpr int LDSCTL_OFF = RING_BYTES, MISC_OFF = LDSCTL_OFF + 320;
constexpr int LDS_BYTES = 147456;
constexpr int NWAVES = 8;
constexpr int CW_TMO = 0, CW_CODE = 1, CW_BAR = 4096;
constexpr int N_PHASES = 7;

struct Args { Ptrs P; int ph_lo, ph_hi, li, pad; };

__device__ __forceinline__ void p6_final(const Ptrs& P, int gw, int NGW, int lane) {
    const float* SS3 = (const float*)(P.ws + WS_SS3);
    for (int m = gw; m < T; m += NGW) {
        const f32x4* sp = (const f32x4*)(SS3 + (size_t)m * 16); const f32x4 s4 = (sp[0] + sp[1]) + (sp[2] + sp[3]);
        const float r = rsqrtf(((s4[0] + s4[1]) + (s4[2] + s4[3])) * (1.f / DM) + EPS);
        f32x4* xr = (f32x4*)(P.out + (size_t)m * DM) + lane; const f32x4* gr = (const f32x4*)P.gf + lane;
#pragma unroll
        for (int j = 0; j < 4; ++j) { f32x4 v = xr[64 * j]; const f32x4 g = gr[64 * j]; v = v * r * g; xr[64 * j] = v; }
    }
}

__global__ void __launch_bounds__(NWAVES * 64, 2) mega_fwd(Args args) {
    extern __shared__ __attribute__((aligned(16))) unsigned char lds[];
    const Ptrs& P = args.P;
    const int tid = threadIdx.x, lane = tid & 63, wave = __builtin_amdgcn_readfirstlane(tid >> 6);
    const int G = gridDim.x; const int bx = blockIdx.x; const int vcu = (G % 8 == 0) ? (bx % 8) * (G / 8) + bx / 8 : bx;
    unsigned char* ws = P.ws;
    unsigned* ctl = (unsigned*)(ws + WS_CTL);
    LAS unsigned char* l3 = (LAS unsigned char*)lds;
    for (int u = tid; u < (LDS_BYTES - LDSCTL_OFF) / 4; u += NWAVES * 64) ((LAS unsigned*)(l3 + LDSCTL_OFF))[u] = 0u;
    __syncthreads();
    XcdBarrier bar = xcd_barrier_post(ctl + CW_BAR + args.li * XCD_BAR_WORDS, (volatile LAS unsigned*)(l3 + MISC_OFF) + 8);
    const int lo = args.ph_lo, hi = args.ph_hi;
#define IN(k) (lo <= (k) && (k) < hi)
#define BOTH(k) (IN(k) && IN((k) + 1))
#define GRID_BAR() xcd_barrier(bar)
    const int gw = vcu * NWAVES + wave, NGW = G * NWAVES;

    if (IN(0)) { p0_prologue(P, (float*)lds, gw, NGW, lane, wave); if (BOTH(0)) GRID_BAR(); }

    if (IN(1)) {
        pg8::Gemm g{(const bf16*)(ws + WS_XB), (const bf16*)(ws + WS_WIN), T, NINP, DM}; pg8::StaticOrder S; S.init(T, NINP, G, (int)blockIdx.x);
        pg8::EpiIn E{ws, P.b_gate, P.pos};
        pg8::gemm_phase<pg8::EpiIn, pg8::StaticOrder, true, true>(l3 + RING_OFF, g, S, E);
        if (BOTH(1)) GRID_BAR();
    }
    if (IN(2)) {
        const int xcd = bx & 7, gi = bx >> 4; const bool isg = ((bx >> 3) & 1) == 0;
        if (isg) gla::gla_unit((char*)lds + RING_OFF, gi * 8 + xcd, (const bf16*)(ws + WS_GQ), (const bf16*)(ws + WS_GK), (const bf16*)(ws + WS_GV), (const float*)(ws + WS_GB), (const bf16*)(ws + WS_GR), (bf16*)(ws + WS_O));
        mb::moba_phase((char*)lds + RING_OFF, (const bf16*)(ws + WS_MQ), (const bf16*)(ws + WS_MK), (const bf16*)(ws + WS_MV), (bf16*)(ws + WS_O), (const float*)(ws + WS_KSUM), xcd, isg ? gi : 16 + 3 * gi, isg ? 1 : 3);
        if (BOTH(2)) GRID_BAR();
    }
    if (IN(3)) {
        pg8::Gemm g{(const bf16*)(ws + WS_O), (const bf16*)(ws + WS_WOUT), T, DM, DM}; pg8::StaticOrder S; S.init(T, DM, G, (int)blockIdx.x);
        pg8::EpiRes<0> E{P.x, nullptr, (bf16*)(ws + WS_XB), (float*)(ws + WS_SS2)};
        pg8::gemm_phase<pg8::EpiRes<0>, pg8::StaticOrder, true, true>(l3 + RING_OFF, g, S, E);
        if (BOTH(3)) GRID_BAR();
    }
    if (IN(4)) {
        pg8::Gemm g{(const bf16*)(ws + WS_XB), (const bf16*)(ws + WS_WGU), T, 2 * DFF, DM}; pg8::StaticOrder S; S.init(T, 2 * DFF, G, (int)blockIdx.x);
        pg8::EpiUp E{(const float*)(ws + WS_SS2), (bf16*)(ws + WS_HMID)};
        pg8::gemm_phase<pg8::EpiUp, pg8::StaticOrder, true, true>(l3 + RING_OFF, g, S, E);
        if (BOTH(4)) GRID_BAR();
    }
    if (IN(5)) {
        pg8::Gemm g{(const bf16*)(ws + WS_HMID), (const bf16*)(ws + WS_WDN), T, DM, DFF}; pg8::StaticOrder S; S.init(T, DM, G, (int)blockIdx.x);
        pg8::EpiRes<1> E{nullptr, P.out, (bf16*)(ws + WS_XB), (float*)(ws + WS_SS3)};
        pg8::gemm_phase<pg8::EpiRes<1>, pg8::StaticOrder, true, true>(l3 + RING_OFF, g, S, E);
        if (BOTH(5)) GRID_BAR();
    }
    if (IN(6)) { p6_final(P, gw, NGW, lane); }
#undef IN
#undef BOTH
#undef GRID_BAR
}

__global__ __launch_bounds__(512) void naive_gla(Ptrs P) {
    __shared__ float qs[64], ks[64], as[64], vs[128], part[4][128], o2[128];
    const int bh = blockIdx.x, tid = threadIdx.x, v = tid & 127, g = tid >> 7;
    const bf16* GQ = (const bf16*)(P.ws + WS_GQ) + (size_t)bh * SEQ * 64; const bf16* GK = (const bf16*)(P.ws + WS_GK) + (size_t)bh * SEQ * 64;
    const bf16* GV = (const bf16*)(P.ws + WS_GV) + (size_t)bh * SEQ * 128; const float* GB = (const float*)(P.ws + WS_GB) + (size_t)bh * SEQ * 64;
    const bf16* GR = (const bf16*)(P.ws + WS_GR); bf16* O = (bf16*)(P.ws + WS_O); const int b = bh >> 2, h = bh & 3;
    float S[16];
    for (int i = 0; i < 16; ++i) S[i] = 0.f;
    for (int s = 0; s < SEQ; ++s) {
        if (tid < 64) { qs[tid] = bf2f(GQ[(size_t)s * 64 + tid]) * 0.125f; ks[tid] = bf2f(GK[(size_t)s * 64 + tid]);
            const float bc = GB[(size_t)s * 64 + tid], bp = (s & 63) ? GB[(size_t)(s - 1) * 64 + tid] : 0.f; as[tid] = __expf(bc - bp); }
        else if (tid < 192) vs[tid - 64] = bf2f(GV[(size_t)s * 128 + tid - 64]);
        __syncthreads();
        float acc = 0.f; const float vv = vs[v];
#pragma unroll
        for (int i = 0; i < 16; ++i) { const int d = g * 16 + i; S[i] = as[d] * S[i] + ks[d] * vv; acc += qs[d] * S[i]; }
        part[g][v] = acc;
        __syncthreads();
        float o = 0.f;
        if (tid < 128) { o = part[0][tid] + part[1][tid] + part[2][tid] + part[3][tid]; o2[tid] = o * o; }
        __syncthreads();
        if (tid < 128) { float ss = 0.f; for (int i = 0; i < 128; ++i) ss += o2[i];
            const size_t t = (size_t)b * SEQ + s; const float rs = rsqrtf(ss * (1.f / 128.f) + EPS);
            O[t * DM + h * 128 + tid] = (bf16)f2bf(o * rs * bf2f(GR[t * 512 + h * 128 + tid])); }
    }
}
__global__ __launch_bounds__(256) void naive_moba(Ptrs P) {
    __shared__ float qsh[4][128]; __shared__ float sc[4][1024];
    const int wave = threadIdx.x >> 6, lane = threadIdx.x & 63; const size_t qi = (size_t)blockIdx.x * 4 + wave;
    const int s = (int)(qi & 2047), bh = (int)(qi >> 11), b = bh >> 2, h = bh & 3, qblk = s >> 8;
    const bf16* MQ = (const bf16*)(P.ws + WS_MQ); const bf16* MK = (const bf16*)(P.ws + WS_MK) + (size_t)bh * SEQ * 128; const bf16* MV = (const bf16*)(P.ws + WS_MV) + (size_t)bh * SEQ * 128;
    const float* KS = (const float*)(P.ws + WS_KSUM);
    float* q = qsh[wave]; float* scw = sc[wave];
    q[lane] = bf2f(MQ[qi * 128 + lane]); q[lane + 64] = bf2f(MQ[qi * 128 + lane + 64]);
    __builtin_amdgcn_s_waitcnt(0xc07f); asm volatile("" ::: "memory");
    float g = -__builtin_inff();
    if (lane < 8 && lane < qblk) { const int pm = b * 8 + lane; float a = 0.f;
        for (int d = 0; d < 128; ++d) a += q[d] * (KS[((size_t)pm * 2) * 512 + h * 128 + d] + KS[((size_t)pm * 2 + 1) * 512 + h * 128 + d]) * (1.f / 256.f);
        g = a; }
    float gv[8];
#pragma unroll
    for (int j = 0; j < 8; ++j) gv[j] = __shfl(g, j);
    unsigned sel = 0;
#pragma unroll
    for (int j = 0; j < 8; ++j) { int rank = 0;
#pragma unroll
        for (int k = 0; k < 8; ++k) if (k < qblk && (gv[k] > gv[j] || (gv[k] == gv[j] && k < j))) ++rank;
        if (j < qblk && rank < 3) sel |= 1u << j; }
    const int nsl = __builtin_popcount(sel) + 1;
    const float scale = 0.08838834764831845f;
    float mx = -__builtin_inff();
    for (int blk = 0; blk <= qblk; ++blk) { const bool own = blk == qblk; if (!own && !((sel >> blk) & 1u)) continue;
        const int sl = own ? nsl - 1 : __builtin_popcount(sel & ((1u << blk) - 1u));
        for (int kk = lane; kk < 256; kk += 64) { const int key = blk * 256 + kk; float a = -__builtin_inff();
        if (key <= s) { a = 0.f; const bf16* kr = MK + (size_t)key * 128; for (int d = 0; d < 128; d += 8) { const v4u w = *(const v4u*)(kr + d);
                a += q[d] * bf2f((unsigned short)w.x) + q[d + 1] * bf2f((unsigned short)(w.x >> 16)) + q[d + 2] * bf2f((unsigned short)w.y) + q[d + 3] * bf2f((unsigned short)(w.y >> 16))
                   + q[d + 4] * bf2f((unsigned short)w.z) + q[d + 5] * bf2f((unsigned short)(w.z >> 16)) + q[d + 6] * bf2f((unsigned short)w.w) + q[d + 7] * bf2f((unsigned short)(w.w >> 16)); }
            a *= scale; }
        scw[sl * 256 + kk] = a; mx = fmaxf(mx, a); } }
    for (int o = 1; o < 64; o <<= 1) mx = fmaxf(mx, __shfl_xor(mx, o));
    float sum = 0.f;
    for (int i = lane; i < nsl * 256; i += 64) { const float p = __expf(scw[i] - mx); scw[i] = p; sum += p; }
    sum = wave_sum(sum);
    __builtin_amdgcn_s_waitcnt(0xc07f); asm volatile("" ::: "memory");
    float o0 = 0.f, o1 = 0.f;
    for (int blk = 0; blk <= qblk; ++blk) { const bool own = blk == qblk; if (!own && !((sel >> blk) & 1u)) continue;
        const int sl = own ? nsl - 1 : __builtin_popcount(sel & ((1u << blk) - 1u));
        const int kmax = own ? (s - qblk * 256 + 1) : 256;
        for (int kk = 0; kk < kmax; ++kk) { const float p = scw[sl * 256 + kk]; const bf16* vr = MV + (size_t)(blk * 256 + kk) * 128; o0 += p * bf2f(vr[lane]); o1 += p * bf2f(vr[lane + 64]); } }
    const float inv = 1.f / sum; o0 *= inv; o1 *= inv;
    const float ss = wave_sum(o0 * o0 + o1 * o1), rs = rsqrtf(ss * (1.f / 128.f) + EPS);
    bf16* O = (bf16*)(P.ws + WS_O); const size_t t = (size_t)b * SEQ + s;
    O[t * DM + 512 + h * 128 + lane] = (bf16)f2bf(o0 * rs); O[t * DM + 512 + h * 128 + lane + 64] = (bf16)f2bf(o1 * rs);
}

extern "C" void kernel_launch(void* const* d_in, const int* in_sizes, int n_in, void* d_out, int out_size, void* d_ws, size_t ws_size, hipStream_t stream) {
    static int grid = 0;
    if (grid == 0) {
        if (n_in != 14 || in_sizes[0] != T * DM || out_size != T * DM || ws_size < WS_END) { fprintf(stderr, "kernel_launch: unexpected shapes (n_in %d, in0 %d, out %d, ws %zu)\n", n_in, n_in > 0 ? in_sizes[0] : -1, out_size, ws_size); grid = -1; return; }
        int dev = 0, cus = 0, per_cu = 0;
        if (hipGetDevice(&dev) != hipSuccess || hipDeviceGetAttribute(&cus, hipDeviceAttributeMultiprocessorCount, dev) != hipSuccess) { grid = -1; return; }
        if (hipFuncSetAttribute((const void*)mega_fwd, hipFuncAttributeMaxDynamicSharedMemorySize, LDS_BYTES) != hipSuccess) { fprintf(stderr, "kernel_launch: hipFuncSetAttribute failed\n"); grid = -1; return; }
        if (hipOccupancyMaxActiveBlocksPerMultiprocessor(&per_cu, (const void*)mega_fwd, NWAVES * 64, LDS_BYTES) != hipSuccess || per_cu < 1) fprintf(stderr, "kernel_launch: occupancy query reports %d\n", per_cu);
        (void)hipGetLastError();
        grid = cus;
        if (grid != 256) { fprintf(stderr, "kernel_launch: built for a 256-CU device (got %d)\n", cus); grid = -1; return; }
    }
    if (grid < 0) return;
    Ptrs P{};
    P.x = (const float*)d_in[0]; P.pos = (const int*)d_in[1]; P.g1 = (const float*)d_in[2]; P.w_in = (const float*)d_in[3]; P.w_gup = (const float*)d_in[4]; P.b_gate = (const float*)d_in[5];
    P.gla_gain = (const float*)d_in[6]; P.moba_gain = (const float*)d_in[7]; P.w_out = (const float*)d_in[8]; P.g2 = (const float*)d_in[9]; P.w_fg = (const float*)d_in[10]; P.w_fu = (const float*)d_in[11];
    P.w_fd = (const float*)d_in[12]; P.gf = (const float*)d_in[13]; P.out = (float*)d_out; P.ws = (unsigned char*)d_ws;
    (void)hipMemsetAsync(P.ws + WS_CTL, 0, CTL_ZERO_BYTES, stream);
    Args a{}; a.P = P;
#ifdef PROBE_DUP
    a.ph_lo = 0; a.ph_hi = PROBE_DUP + 1; a.li = 0;
    hipLaunchKernelGGL(mega_fwd, dim3(grid), dim3(NWAVES * 64), LDS_BYTES, stream, a);
    a.ph_lo = PROBE_DUP; a.ph_hi = N_PHASES; a.li = 1;
    hipLaunchKernelGGL(mega_fwd, dim3(grid), dim3(NWAVES * 64), LDS_BYTES, stream, a);
#else
    a.ph_lo = 0; a.ph_hi = N_PHASES; a.li = 0;
    hipLaunchKernelGGL(mega_fwd, dim3(grid), dim3(NWAVES * 64), LDS_BYTES, stream, a);
#endif
}
```
